# Optimizing an MI355X kernel written in HIP

```python
import math
import jax, jax.numpy as jnp
from jax import lax
import numpy as np


D_MODEL = 2048
BATCH = 4
SEQ = 2048
DEPTH = 1

GRID_W = 64
CTX_LEN = 256

D_MIX = D_MODEL
D_SSM = D_MIX // 2
D_CONV = D_MIX - D_SSM
SSM_GROUP = 16
SSM_GROUPS = D_SSM // SSM_GROUP
SSM_STATE = 64
DT_MIN = 1e-3
DT_MAX = 1e-1
CONV_WIDTH = 3
IN_SPLITS = (D_SSM, D_SSM + D_CONV, D_SSM + 2 * D_CONV)
D_IN = D_SSM + 3 * D_CONV

N_EXPERTS = 64
N_EXPERT_GROUPS = 8
TOPK_GROUPS = 4
TOP_K = 8
D_EXPERT = 512
D_SHARED = 512
ROUTED_SCALE = 2.5
EXPERT_BLOCK = 128

N_MOD = 6
EPS = 1e-6

kernel_name = 'hybrid_s5_shortconv_moe_dit_layer'


def rmsnorm(x, g):
    xf = x.astype(jnp.float32)
    y = xf * lax.rsqrt(jnp.mean(xf * xf, axis=-1, keepdims=True) + EPS)
    return y.astype(x.dtype) * g


def swiglu(x, wg, wu, wd):
    return (jax.nn.silu(x @ wg) * (x @ wu)) @ wd


def zoh(lam_re, lam_im, b_re, b_im, log_dt):
    lam = lax.complex(lam_re.astype(jnp.float32), lam_im.astype(jnp.float32))
    dt = jnp.exp(log_dt.astype(jnp.float32))[:, None]
    lam_bar = jnp.exp(lam * dt)
    b = lax.complex(b_re.astype(jnp.float32), b_im.astype(jnp.float32))
    b_bar = ((lam_bar - 1.0) / lam)[..., None] * b
    return lam_bar, b_bar


def _ssm_combine(left, right):
    a1, b1 = left
    a2, b2 = right
    return a1 * a2, a2 * b1 + b2


def linear_scan(bu, lam_bar, h0, reverse):
    if reverse:
        bu = jnp.flip(bu, axis=1)
    if h0 is not None:
        bu = bu.at[:, 0].add(lam_bar * h0)
    a = jnp.broadcast_to(lam_bar, (1, bu.shape[1]) + lam_bar.shape)
    _, h = lax.associative_scan(_ssm_combine, (a, bu), axis=1)
    return jnp.flip(h, axis=1) if reverse else h


def ssm_readout(h, c_mat):
    y = jnp.einsum('blgp,gnp->blgn', h, c_mat).real
    return y.reshape(h.shape[0], h.shape[1], D_SSM)


def s5_glu(y, w_glu):
    g = jax.nn.gelu(y)
    ga, gb = jnp.split(g @ w_glu, 2, axis=-1)
    return ga * jax.nn.sigmoid(gb)


def s5_bidirectional(ux, uc, lam_re, lam_im, b_re, b_im, c_re, c_im, log_dt, d_skip, w_glu, ctx_out):
    bsz, seq, _ = ux.shape
    ugx = ux.astype(jnp.float32).reshape(bsz, seq, SSM_GROUPS, SSM_GROUP)
    ugc = uc.astype(jnp.float32).reshape(bsz, uc.shape[1], SSM_GROUPS, SSM_GROUP)
    yx = d_skip * ux
    yc = d_skip * uc if ctx_out else None
    for d in range(2):
        rev = d == 1
        lam_bar, b_bar = zoh(lam_re[d], lam_im[d], b_re[d], b_im[d], log_dt[d])
        c_mat = lax.complex(c_re[d].astype(jnp.float32), c_im[d].astype(jnp.float32))
        hc = linear_scan(jnp.einsum('blgn,gpn->blgp', ugc, b_bar), lam_bar, None, rev)
        h0 = hc[:, 0] if rev else hc[:, -1]
        hx = linear_scan(jnp.einsum('blgn,gpn->blgp', ugx, b_bar), lam_bar, h0, rev)
        yx = yx + ssm_readout(hx, c_mat).astype(ux.dtype)
        if ctx_out:
            yc = yc + ssm_readout(hc, c_mat).astype(uc.dtype)
    return s5_glu(yx, w_glu), (s5_glu(yc, w_glu) if ctx_out else None)


def centred_conv(z, w, b):
    pad = CONV_WIDTH // 2
    n = z.shape[-2]
    zp = jnp.pad(z, [(0, 0)] * (z.ndim - 2) + [(pad, pad), (0, 0)])
    out = b
    for j in range(CONV_WIDTH):
        out = out + zp[..., j:j + n, :] * w[j]
    return out


def short_conv_mixer(bg, cg, v, w, b, rows):
    z = cg * v
    if rows is None:
        y = centred_conv(z, w, b)
    else:
        bsz, seq, ch = z.shape
        y = centred_conv(z.reshape(bsz, rows, GRID_W, ch), w, b).reshape(bsz, seq, ch)
    return bg * y


def merge_heads(ssm_y, conv_y, mix_norm_g, w_out):
    heads = jnp.concatenate([rmsnorm(ssm_y, mix_norm_g[:D_SSM]),
                             rmsnorm(conv_y, mix_norm_g[D_SSM:])], axis=-1)
    return heads @ w_out


def route(h, router_w, router_bias):
    t = h.shape[0]
    scores = jax.nn.sigmoid((h @ router_w).astype(jnp.float32))
    biased = scores + router_bias.astype(jnp.float32)
    grouped = biased.reshape(t, N_EXPERT_GROUPS, N_EXPERTS // N_EXPERT_GROUPS)
    group_score = jnp.sum(lax.top_k(grouped, 2)[0], axis=-1)
    _, top_groups = lax.top_k(group_score, TOPK_GROUPS)
    group_mask = jnp.sum(jax.nn.one_hot(top_groups, N_EXPERT_GROUPS, dtype=jnp.float32), axis=-2) > 0
    expert_mask = jnp.repeat(group_mask, N_EXPERTS // N_EXPERT_GROUPS, axis=-1)
    _, idx = lax.top_k(jnp.where(expert_mask, biased, -jnp.inf), TOP_K)
    w = jnp.take_along_axis(scores, idx, axis=-1)
    w = w / jnp.sum(w, axis=-1, keepdims=True) * ROUTED_SCALE
    return idx, w


def routed_experts(h, idx, wts, w_gate, w_up, w_down):
    t, d = h.shape
    n_assign = t * TOP_K
    flat_e = idx.reshape(n_assign)
    flat_tok = jnp.repeat(jnp.arange(t, dtype=jnp.int32), TOP_K)
    flat_w = wts.reshape(n_assign)
    order = jnp.argsort(flat_e)
    se, stok, sw = flat_e[order], flat_tok[order], flat_w[order]
    counts = jnp.bincount(flat_e, length=N_EXPERTS)
    starts = jnp.cumsum(counts) - counts
    padded = (counts + EXPERT_BLOCK - 1) // EXPERT_BLOCK * EXPERT_BLOCK
    pends = jnp.cumsum(padded)
    pstarts = pends - padded
    dest = pstarts[se] + (jnp.arange(n_assign) - starts[se])
    n_blocks = -(-n_assign // EXPERT_BLOCK) + N_EXPERTS
    n_rows = n_blocks * EXPERT_BLOCK
    rows_tok = jnp.zeros((n_rows,), jnp.int32).at[dest].set(stok)
    rows_w = jnp.zeros((n_rows,), h.dtype).at[dest].set(sw.astype(h.dtype))
    block_start = jnp.arange(n_blocks, dtype=pends.dtype) * EXPERT_BLOCK
    block_e = jnp.minimum(jnp.searchsorted(pends, block_start, side='right'), N_EXPERTS - 1)

    def block_ffn(args):
        tok, e = args
        return swiglu(h[tok], w_gate[e], w_up[e], w_down[e])

    ys = lax.map(block_ffn, (rows_tok.reshape(n_blocks, EXPERT_BLOCK), block_e))
    ys = ys.reshape(n_rows, d) * rows_w[:, None]
    return jnp.zeros_like(h).at[rows_tok].add(ys)


def moe_ffn(h, router_w, router_bias, w_gate, w_up, w_down, ws_gate, ws_up, ws_down):
    shape = h.shape
    ht = h.reshape(-1, shape[-1])
    idx, wts = route(ht, router_w, router_bias)
    routed = routed_experts(ht, idx, wts, w_gate, w_up, w_down)
    shared = swiglu(ht, ws_gate, ws_up, ws_down)
    return (routed + shared).reshape(shape)


def setup_inputs(seed: int = 0) -> dict:
    key = jax.random.key(seed)
    ks = jax.random.split(key, 32)
    f32 = jnp.float32

    def nrm(k, shape, scale):
        return jax.random.normal(k, shape, f32) * scale

    n_idx = jnp.arange(SSM_STATE, dtype=f32)
    return {
        'x': nrm(ks[0], (BATCH, SEQ, D_MODEL), 1.0),
        'c': nrm(ks[1], (BATCH, D_MODEL), 1.0),
        'ctx': nrm(ks[2], (BATCH, CTX_LEN, D_MODEL), 1.0),
        'c_ctx': nrm(ks[3], (D_MODEL,), 1.0),
        'norm1_g': 1.0 + nrm(ks[4], (DEPTH, D_MODEL), 0.02),
        'norm2_g': 1.0 + nrm(ks[5], (DEPTH, D_MODEL), 0.02),
        'w_ada': nrm(ks[6], (DEPTH, D_MODEL, N_MOD * D_MODEL), 0.5 * D_MODEL ** -0.5),
        'b_ada': nrm(ks[7], (DEPTH, N_MOD * D_MODEL), 0.02),
        'w_in': nrm(ks[8], (DEPTH, D_MODEL, D_IN), D_MODEL ** -0.5),
        'ssm_lam_re': -0.5 + nrm(ks[9], (DEPTH, 2, SSM_GROUPS, SSM_STATE), 0.01),
        'ssm_lam_im': math.pi * n_idx + nrm(ks[10], (DEPTH, 2, SSM_GROUPS, SSM_STATE), 0.01),
        'ssm_b_re': nrm(ks[11], (DEPTH, 2, SSM_GROUPS, SSM_STATE, SSM_GROUP), (2 * SSM_GROUP) ** -0.5),
        'ssm_b_im': nrm(ks[12], (DEPTH, 2, SSM_GROUPS, SSM_STATE, SSM_GROUP), (2 * SSM_GROUP) ** -0.5),
        'ssm_c_re': nrm(ks[13], (DEPTH, 2, SSM_GROUPS, SSM_GROUP, SSM_STATE), (2 * SSM_STATE) ** -0.5),
        'ssm_c_im': nrm(ks[14], (DEPTH, 2, SSM_GROUPS, SSM_GROUP, SSM_STATE), (2 * SSM_STATE) ** -0.5),
        'ssm_log_dt': jax.random.uniform(ks[15], (DEPTH, 2, SSM_GROUPS), f32,
                                         minval=math.log(DT_MIN), maxval=math.log(DT_MAX)),
        'ssm_d': nrm(ks[16], (DEPTH, D_SSM), 0.5),
        'ssm_w_glu': nrm(ks[17], (DEPTH, D_SSM, 2 * D_SSM), D_SSM ** -0.5),
        'conv_w': nrm(ks[18], (DEPTH, CONV_WIDTH, D_CONV), CONV_WIDTH ** -0.5),
        'conv_b': nrm(ks[19], (DEPTH, D_CONV), 0.01),
        'mix_norm_g': 1.0 + nrm(ks[20], (DEPTH, D_MIX), 0.02),
        'w_out': nrm(ks[21], (DEPTH, D_MIX, D_MODEL), D_MIX ** -0.5),
        'router_w': nrm(ks[22], (DEPTH, D_MODEL, N_EXPERTS), D_MODEL ** -0.5),
        'router_bias': nrm(ks[23], (DEPTH, N_EXPERTS), 0.01),
        'exp_w_gate': nrm(ks[24], (DEPTH, N_EXPERTS, D_MODEL, D_EXPERT), D_MODEL ** -0.5),
        'exp_w_up': nrm(ks[25], (DEPTH, N_EXPERTS, D_MODEL, D_EXPERT), D_MODEL ** -0.5),
        'exp_w_down': nrm(ks[26], (DEPTH, N_EXPERTS, D_EXPERT, D_MODEL), D_EXPERT ** -0.5),
        'shared_w_gate': nrm(ks[27], (DEPTH, D_MODEL, D_SHARED), D_MODEL ** -0.5),
        'shared_w_up': nrm(ks[28], (DEPTH, D_MODEL, D_SHARED), D_MODEL ** -0.5),
        'shared_w_down': nrm(ks[29], (DEPTH, D_SHARED, D_MODEL), D_SHARED ** -0.5),
        'final_g': 1.0 + nrm(ks[30], (D_MODEL,), 0.02),
    }


def reference(x, c, ctx, c_ctx, norm1_g, norm2_g, w_ada, b_ada, w_in,
              ssm_lam_re, ssm_lam_im, ssm_b_re, ssm_b_im, ssm_c_re, ssm_c_im, ssm_log_dt,
              ssm_d, ssm_w_glu, conv_w, conv_b, mix_norm_g, w_out,
              router_w, router_bias, exp_w_gate, exp_w_up, exp_w_down,
              shared_w_gate, shared_w_up, shared_w_down, final_g):
    rows = x.shape[1] // GRID_W
    for layer in range(DEPTH):
        ctx_out = layer < DEPTH - 1
        mod_x = jnp.split(jax.nn.silu(c) @ w_ada[layer] + b_ada[layer], N_MOD, axis=-1)
        sh1, sc1, g1, sh2, sc2, g2 = [m[:, None, :] for m in mod_x]
        csh1, csc1, cg1, csh2, csc2, cg2 = jnp.split(
            jax.nn.silu(c_ctx) @ w_ada[layer] + b_ada[layer], N_MOD, axis=-1)

        hx = rmsnorm(x, norm1_g[layer]) * (1 + sc1) + sh1
        hc = rmsnorm(ctx, norm1_g[layer]) * (1 + csc1) + csh1
        ux, bx, cx, vx = jnp.split(hx @ w_in[layer], IN_SPLITS, axis=-1)
        if ctx_out:
            uc, bc, cc, vc = jnp.split(hc @ w_in[layer], IN_SPLITS, axis=-1)
        else:
            uc = hc @ w_in[layer][:, :D_SSM]
        ssm_x, ssm_c = s5_bidirectional(ux, uc, ssm_lam_re[layer], ssm_lam_im[layer],
                                        ssm_b_re[layer], ssm_b_im[layer], ssm_c_re[layer],
                                        ssm_c_im[layer], ssm_log_dt[layer], ssm_d[layer],
                                        ssm_w_glu[layer], ctx_out)
        conv_x = short_conv_mixer(bx, cx, vx, conv_w[layer], conv_b[layer], rows)
        x = x + g1 * merge_heads(ssm_x, conv_x, mix_norm_g[layer], w_out[layer])

        hx2 = rmsnorm(x, norm2_g[layer]) * (1 + sc2) + sh2
        x = x + g2 * moe_ffn(hx2, router_w[layer], router_bias[layer], exp_w_gate[layer],
                             exp_w_up[layer], exp_w_down[layer], shared_w_gate[layer],
                             shared_w_up[layer], shared_w_down[layer])

        if ctx_out:
            conv_c = short_conv_mixer(bc, cc, vc, conv_w[layer], conv_b[layer], None)
            ctx = ctx + cg1 * merge_heads(ssm_c, conv_c, mix_norm_g[layer], w_out[layer])
            hc2 = rmsnorm(ctx, norm2_g[layer]) * (1 + csc2) + csh2
            ctx = ctx + cg2 * moe_ffn(hc2, router_w[layer], router_bias[layer], exp_w_gate[layer],
                                      exp_w_up[layer], exp_w_down[layer], shared_w_gate[layer],
                                      shared_w_up[layer], shared_w_down[layer])
    return rmsnorm(x, final_g)
```

```cpp
#include <hip/hip_runtime.h>
#include <cstdio>
#include <cstdint>

typedef unsigned short bf16;
__device__ __forceinline__ unsigned f2bf(float f) { unsigned u = __builtin_bit_cast(unsigned, f); return (u + 0x7fffu + ((u >> 16) & 1u)) >> 16; }
__device__ __forceinline__ float bf2f(bf16 h) { return __builtin_bit_cast(float, (unsigned)h << 16); }

constexpr int D = 2048, NB = 4, SEQ = 2048, T = NB * SEQ, CTXL = 256, TC = NB * CTXL, TR = T + TC;
constexpr int DS = 1024, NMOD = 6, NE = 64, TOPK = 8, DE = 512;
constexpr float EPS = 1e-6f;
constexpr size_t MiB = 1u << 20;
constexpr size_t WS_CTL = 0, CTL_ZERO = 1 * MiB;
constexpr size_t CW_CNT = 1024;
constexpr size_t CW_SEG = 2048;
constexpr size_t CW_RS_SSM = 16384, CW_RS_X1 = 32768;
constexpr size_t WS_MOD = 1 * MiB;
constexpr size_t WS_POS = 2 * MiB;
constexpr size_t WS_WTS = 3 * MiB;
constexpr size_t WS_ROWS = 4 * MiB;
constexpr size_t WS_XN = 8 * MiB;
constexpr size_t WS_U = 44 * MiB;
constexpr size_t WS_BG = 62 * MiB;
constexpr size_t WS_Z = 78 * MiB;
constexpr size_t WS_GY = 94 * MiB;
constexpr size_t WS_HEADS = 110 * MiB;
constexpr size_t WS_ACT = 44 * MiB;
constexpr size_t WS_YS = 142 * MiB;
constexpr size_t WS_W = 494 * MiB;
constexpr size_t WS_END = 912 * MiB;

struct P {
    const float *x, *c, *ctx, *c_ctx, *norm1_g, *norm2_g, *w_ada, *b_ada, *w_in, *lam_re, *lam_im, *b_re, *b_im, *c_re, *c_im, *log_dt,
        *ssm_d, *w_glu, *conv_w, *conv_b, *mix_g, *w_out, *router_w, *router_b, *e_gate, *e_up, *e_down, *s_gate, *s_up, *s_down, *final_g;
    float* out; unsigned char* ws;
};
__device__ __forceinline__ float siluf(float v) { return v / (1.f + __expf(-v)); }
__device__ __forceinline__ float sigmf(float v) { return 1.f / (1.f + __expf(-v)); }
__device__ __forceinline__ float gelu_tanh(float v) { const float u = 0.7978845608028654f * (v + 0.044715f * v * v * v); return 0.5f * v * (1.f + tanhf(u)); }

__device__ __forceinline__ float block_sum256(float v, float* red) {
#pragma unroll
    for (int o = 32; o > 0; o >>= 1) v += __shfl_xor(v, o);
    __syncthreads();
    if ((threadIdx.x & 63) == 0) red[threadIdx.x >> 6] = v;
    __syncthreads();
    return red[0] + red[1] + red[2] + red[3];
}

__global__ void __launch_bounds__(256) k_mod(P p) {
    __shared__ float s[5][2048];
    __shared__ float part[4][5][64];
    for (int i = threadIdx.x; i < 5 * 2048; i += 256) { const int r = i / 2048, k = i % 2048; const float v = r < 4 ? p.c[r * 2048 + k] : p.c_ctx[k]; s[r][k] = siluf(v); }
    __syncthreads();
    const int col = blockIdx.x * 64 + (threadIdx.x & 63), kq = threadIdx.x >> 6;
    float acc[5] = {0, 0, 0, 0, 0};
    for (int k = kq * 512; k < kq * 512 + 512; ++k) { const float w = p.w_ada[(size_t)k * 12288 + col];
#pragma unroll
        for (int r = 0; r < 5; ++r) acc[r] += s[r][k] * w; }
#pragma unroll
    for (int r = 0; r < 5; ++r) part[kq][r][threadIdx.x & 63] = acc[r];
    __syncthreads();
    if (kq == 0) { float* mod = (float*)(p.ws + WS_MOD);
#pragma unroll
        for (int r = 0; r < 5; ++r) mod[r * 12288 + col] = part[0][r][threadIdx.x] + part[1][r][threadIdx.x] + part[2][r][threadIdx.x] + part[3][r][threadIdx.x] + p.b_ada[col]; }
}
__global__ void __launch_bounds__(256) k_norm1(P p) {
    __shared__ float red[4];
    const int r = blockIdx.x; const float* src = r < T ? p.x + (size_t)r * D : p.ctx + (size_t)(r - T) * D; const int b = r < T ? r / SEQ : 4;
    const float* mod = (const float*)(p.ws + WS_MOD) + b * 12288;
    float v[8]; float ss = 0.f;
#pragma unroll
    for (int j = 0; j < 8; ++j) { v[j] = src[threadIdx.x + 256 * j]; ss += v[j] * v[j]; }
    ss = block_sum256(ss, red);
    const float rs = rsqrtf(ss * (1.f / D) + EPS);
    bf16* o = (bf16*)(p.ws + WS_XN) + (size_t)r * D;
#pragma unroll
    for (int j = 0; j < 8; ++j) { const int k = threadIdx.x + 256 * j; const float y = (v[j] * rs) * p.norm1_g[k]; o[k] = (bf16)f2bf(y * (1.f + mod[2048 + k]) + mod[k]); }
}
template <class F> __global__ void __launch_bounds__(256) k_gemm(P p) {
    const F f{};
    __shared__ float As[16][65]; __shared__ float B1s[16][64]; __shared__ float B2s[16][64];
    const int z = blockIdx.z, Mz = f.M(p, z), tm = blockIdx.y * 64, tn = blockIdx.x * 64;
    if (tm >= Mz) return;
    const int tid = threadIdx.x, tx = tid & 15, ty = tid >> 4;
    float a1[4][4], a2[4][4];
#pragma unroll
    for (int i = 0; i < 4; ++i)
#pragma unroll
        for (int j = 0; j < 4; ++j) { a1[i][j] = 0.f; a2[i][j] = 0.f; }
    for (int k0 = 0; k0 < F::K; k0 += 16) {
#pragma unroll
        for (int i = 0; i < 4; ++i) { const int idx = tid + i * 256, r = idx >> 4, kk = idx & 15; const int m = tm + r; As[kk][r] = m < Mz ? f.a(p, z, m, k0 + kk) : 0.f; }
#pragma unroll
        for (int i = 0; i < 4; ++i) { const int idx = tid + i * 256, kk = idx >> 6, n = idx & 63; B1s[kk][n] = f.b1(p, z, k0 + kk, tn + n); B2s[kk][n] = F::DUAL ? f.b2(p, z, k0 + kk, tn + n) : 0.f; }
        __syncthreads();
#pragma unroll
        for (int kk = 0; kk < 16; ++kk) { float av[4], bv[4], cv[4];
#pragma unroll
            for (int i = 0; i < 4; ++i) av[i] = As[kk][ty * 4 + i];
#pragma unroll
            for (int j = 0; j < 4; ++j) { bv[j] = B1s[kk][tx * 4 + j]; cv[j] = B2s[kk][tx * 4 + j]; }
#pragma unroll
            for (int i = 0; i < 4; ++i)
#pragma unroll
                for (int j = 0; j < 4; ++j) { a1[i][j] += av[i] * bv[j]; if (F::DUAL) a2[i][j] += av[i] * cv[j]; } }
        __syncthreads();
    }
#pragma unroll
    for (int i = 0; i < 4; ++i) { const int m = tm + ty * 4 + i; float rowacc = 0.f;
        if (m < Mz) {
#pragma unroll
            for (int j = 0; j < 4; ++j) f.epi(p, z, m, tn + tx * 4 + j, a1[i][j], a2[i][j], rowacc); }
        if (F::ROWSUM) { rowacc += __shfl_xor(rowacc, 1); rowacc += __shfl_xor(rowacc, 2); rowacc += __shfl_xor(rowacc, 4); rowacc += __shfl_xor(rowacc, 8);
            if (tx == 0 && m < Mz) f.rowsum(p, z, m, rowacc); } }
}
struct FInProj { static constexpr int K = 2048; static constexpr bool DUAL = true, ROWSUM = false;
    __device__ int M(const P&, int) const { return TR; }
    __device__ float a(const P& p, int, int m, int k) const { return bf2f(((const bf16*)(p.ws + WS_XN))[(size_t)m * D + k]); }
    __device__ float b1(const P& p, int, int k, int n) const { return p.w_in[(size_t)k * 4096 + n]; }
    __device__ float b2(const P& p, int, int k, int n) const { return p.w_in[(size_t)k * 4096 + n + (n >= 2048 ? 1024 : 0)]; }
    __device__ void epi(const P& p, int, int m, int n, float v1, float v2, float&) const {
        if (n < 1024) ((bf16*)(p.ws + WS_U))[(size_t)m * DS + n] = (bf16)f2bf(v1);
        else if (m < T) { if (n < 2048) ((bf16*)(p.ws + WS_BG))[(size_t)m * DS + n - 1024] = (bf16)f2bf(v1); else ((bf16*)(p.ws + WS_Z))[(size_t)m * DS + n - 2048] = (bf16)f2bf(v1 * v2); } }
    __device__ void rowsum(const P&, int, int, float) const {}
};
struct FGlu { static constexpr int K = 1024; static constexpr bool DUAL = true, ROWSUM = true;
    __device__ int M(const P&, int) const { return T; }
    __device__ float a(const P& p, int, int m, int k) const { return bf2f(((const bf16*)(p.ws + WS_GY))[(size_t)m * DS + k]); }
    __device__ float b1(const P& p, int, int k, int n) const { return p.w_glu[(size_t)k * 2048 + n]; }
    __device__ float b2(const P& p, int, int k, int n) const { return p.w_glu[(size_t)k * 2048 + n + 1024]; }
    __device__ void epi(const P& p, int, int m, int n, float v1, float v2, float& ra) const { const float s = v1 * sigmf(v2); ra += s * s; ((bf16*)(p.ws + WS_HEADS))[(size_t)m * D + n] = (bf16)f2bf(s * p.mix_g[n]); }
    __device__ void rowsum(const P& p, int, int m, float s) const { atomicAdd((float*)p.ws + CW_RS_SSM + m, s); }
};
struct FOut { static constexpr int K = 2048; static constexpr bool DUAL = false, ROWSUM = true;
    __device__ int M(const P&, int) const { return T; }
    __device__ float a(const P& p, int, int m, int k) const { const float v = bf2f(((const bf16*)(p.ws + WS_HEADS))[(size_t)m * D + k]);
        return k < 1024 ? v * rsqrtf(((const float*)p.ws)[CW_RS_SSM + m] * (1.f / 1024.f) + EPS) : v; }
    __device__ float b1(const P& p, int, int k, int n) const { return p.w_out[(size_t)k * D + n]; }
    __device__ float b2(const P&, int, int, int) const { return 0.f; }
    __device__ void epi(const P& p, int, int m, int n, float v1, float, float& ra) const { const int b = m / SEQ; const float g1 = ((const float*)(p.ws + WS_MOD))[b * 12288 + 2 * 2048 + n];
        const float x1 = p.x[(size_t)m * D + n] + g1 * v1; ra += x1 * x1; p.out[(size_t)m * D + n] = x1; }
    __device__ void rowsum(const P& p, int, int m, float s) const { atomicAdd((float*)p.ws + CW_RS_X1 + m, s); }
};
struct FAct { static constexpr int K = 2048; static constexpr bool DUAL = true, ROWSUM = false;
    __device__ int M(const P& p, int z) const { return z < NE ? (int)((const unsigned*)p.ws)[CW_CNT + z] : T; }
    __device__ float a(const P& p, int z, int m, int k) const { const int tok = z < NE ? ((const int*)(p.ws + WS_ROWS))[z * 8192 + m] : m; return bf2f(((const bf16*)(p.ws + WS_XN))[(size_t)tok * D + k]); }
    __device__ float b1(const P& p, int z, int k, int n) const { return (z < NE ? p.e_gate + (size_t)z * D * DE : p.s_gate)[(size_t)k * DE + n]; }
    __device__ float b2(const P& p, int z, int k, int n) const { return (z < NE ? p.e_up + (size_t)z * D * DE : p.s_up)[(size_t)k * DE + n]; }
    __device__ void epi(const P& p, int z, int m, int n, float v1, float v2, float&) const { const unsigned row = ((const unsigned*)p.ws)[CW_SEG + z] + m; ((bf16*)(p.ws + WS_ACT))[(size_t)row * DE + n] = (bf16)f2bf(siluf(v1) * v2); }
    __device__ void rowsum(const P&, int, int, float) const {}
};
struct FY { static constexpr int K = 512; static constexpr bool DUAL = false, ROWSUM = false;
    __device__ int M(const P& p, int z) const { return z < NE ? (int)((const unsigned*)p.ws)[CW_CNT + z] : T; }
    __device__ float a(const P& p, int z, int m, int k) const { const unsigned row = ((const unsigned*)p.ws)[CW_SEG + z] + m; return bf2f(((const bf16*)(p.ws + WS_ACT))[(size_t)row * DE + k]); }
    __device__ float b1(const P& p, int z, int k, int n) const { return (z < NE ? p.e_down + (size_t)z * DE * D : p.s_down)[(size_t)k * D + n]; }
    __device__ float b2(const P&, int, int, int) const { return 0.f; }
    __device__ void epi(const P& p, int z, int m, int n, float v1, float, float&) const { const unsigned row = ((const unsigned*)p.ws)[CW_SEG + z] + m; ((bf16*)(p.ws + WS_YS))[(size_t)row * D + n] = (bf16)f2bf(v1); }
    __device__ void rowsum(const P&, int, int, float) const {}
};
__global__ void __launch_bounds__(64) k_ssm(P p) {
    __shared__ float hs[2][64]; __shared__ float cs[2][16][64];
    const int b = blockIdx.x, g = blockIdx.y, d = blockIdx.z, pp = threadIdx.x;
    const int gi = (d * 64 + g) * 64 + pp;
    const double lre = p.lam_re[gi], lim = p.lam_im[gi], dt = exp((double)p.log_dt[d * 64 + g]);
    const double er = exp(lre * dt), lbr = er * cos(lim * dt), lbi = er * sin(lim * dt);
    const double nr = lbr - 1.0, ni = lbi, den = lre * lre + lim * lim; const double cr = (nr * lre + ni * lim) / den, ci = (ni * lre - nr * lim) / den;
    float bbr[16], bbi[16];
#pragma unroll
    for (int n = 0; n < 16; ++n) { const double br = p.b_re[(size_t)gi * 16 + n], bi = p.b_im[(size_t)gi * 16 + n]; bbr[n] = (float)(cr * br - ci * bi); bbi[n] = (float)(cr * bi + ci * br); }
    for (int n = 0; n < 16; ++n) { cs[0][n][pp] = p.c_re[((size_t)(d * 64 + g) * 16 + n) * 64 + pp]; cs[1][n][pp] = p.c_im[((size_t)(d * 64 + g) * 16 + n) * 64 + pp]; }
    __syncthreads();
    const float lr = (float)lbr, li = (float)lbi; float hr = 0.f, hi = 0.f;
    const bf16* U = (const bf16*)(p.ws + WS_U); float* Y = (float*)(p.ws + WS_W) + (size_t)d * T * DS;
    const int n_ = pp & 15, q = pp >> 4;
    for (int step = 0; step < CTXL + SEQ; ++step) {
        int row; const bool isx = step >= CTXL;
        if (!isx) { const int t = d == 0 ? step : CTXL - 1 - step; row = T + b * CTXL + t; } else { const int s = step - CTXL; const int t = d == 0 ? s : SEQ - 1 - s; row = b * SEQ + t; }
        const bf16* ur = U + (size_t)row * DS + g * 16; float br = 0.f, bi = 0.f;
#pragma unroll
        for (int n = 0; n < 16; ++n) { const float u = bf2f(ur[n]); br += bbr[n] * u; bi += bbi[n] * u; }
        const float nhr = lr * hr - li * hi + br, nhi = lr * hi + li * hr + bi; hr = nhr; hi = nhi;
        if (isx) {
            hs[0][pp] = hr; hs[1][pp] = hi; __syncthreads();
            float y = 0.f;
#pragma unroll
            for (int j = 0; j < 16; ++j) { const int ps = q * 16 + j; y += cs[0][n_][ps] * hs[0][ps] - cs[1][n_][ps] * hs[1][ps]; }
            y += __shfl_xor(y, 16); y += __shfl_xor(y, 32);
            if (q == 0) Y[(size_t)row * DS + g * 16 + n_] = y;
            __syncthreads();
        }
    }
}
__global__ void __launch_bounds__(256) k_gy(P p) {
    const size_t i = (size_t)blockIdx.x * 256 + threadIdx.x; const int ch = (int)(i % DS);
    const float* Y = (const float*)(p.ws + WS_W); const float u = bf2f(((const bf16*)(p.ws + WS_U))[i]);
    const float y = p.ssm_d[ch] * u + Y[i] + Y[(size_t)T * DS + i];
    ((bf16*)(p.ws + WS_GY))[i] = (bf16)f2bf(gelu_tanh(y));
}
__global__ void __launch_bounds__(256) k_conv(P p) {
    __shared__ float red[4];
    const int m = blockIdx.x, i = m & 63; const bf16* Z = (const bf16*)(p.ws + WS_Z); const bf16* BG = (const bf16*)(p.ws + WS_BG);
    float cy[4]; float ss = 0.f;
#pragma unroll
    for (int j = 0; j < 4; ++j) { const int ch = threadIdx.x + 256 * j;
        const float zc = bf2f(Z[(size_t)m * DS + ch]), zl = i > 0 ? bf2f(Z[(size_t)(m - 1) * DS + ch]) : 0.f, zr = i < 63 ? bf2f(Z[(size_t)(m + 1) * DS + ch]) : 0.f;
        const float y = p.conv_b[ch] + p.conv_w[ch] * zl + p.conv_w[DS + ch] * zc + p.conv_w[2 * DS + ch] * zr;
        cy[j] = bf2f(BG[(size_t)m * DS + ch]) * y; ss += cy[j] * cy[j]; }
    ss = block_sum256(ss, red); const float rs = rsqrtf(ss * (1.f / DS) + EPS);
#pragma unroll
    for (int j = 0; j < 4; ++j) { const int ch = threadIdx.x + 256 * j; ((bf16*)(p.ws + WS_HEADS))[(size_t)m * D + DS + ch] = (bf16)f2bf(cy[j] * rs * p.mix_g[DS + ch]); }
}
__global__ void __launch_bounds__(256) k_norm2_route(P p) {
    __shared__ float red[4]; __shared__ float h[2048]; __shared__ float part[4][64]; __shared__ float sc[64];
    const int m = blockIdx.x, b = m / SEQ; const float* mod = (const float*)(p.ws + WS_MOD) + b * 12288;
    float v[8]; float ss = 0.f;
#pragma unroll
    for (int j = 0; j < 8; ++j) { v[j] = p.out[(size_t)m * D + threadIdx.x + 256 * j]; ss += v[j] * v[j]; }
    ss = block_sum256(ss, red); const float rs = rsqrtf(ss * (1.f / D) + EPS);
#pragma unroll
    for (int j = 0; j < 8; ++j) { const int k = threadIdx.x + 256 * j; const float y = (v[j] * rs) * p.norm2_g[k]; const float hx = y * (1.f + mod[4 * 2048 + k]) + mod[3 * 2048 + k]; h[k] = hx;
        ((bf16*)(p.ws + WS_XN))[(size_t)m * D + k] = (bf16)f2bf(hx); }
    __syncthreads();
    { const int e = threadIdx.x & 63, q = threadIdx.x >> 6; float a = 0.f; for (int k = q * 512; k < q * 512 + 512; ++k) a += h[k] * p.router_w[(size_t)k * NE + e]; part[q][e] = a; }
    __syncthreads();
    if (threadIdx.x < 64) sc[threadIdx.x] = sigmf(part[0][threadIdx.x] + part[1][threadIdx.x] + part[2][threadIdx.x] + part[3][threadIdx.x]);
    __syncthreads();
    __shared__ float biased[64]; __shared__ float gs[8]; __shared__ int idx[8];
    if (threadIdx.x < 64) biased[threadIdx.x] = sc[threadIdx.x] + p.router_b[threadIdx.x];
    __syncthreads();
    if (threadIdx.x == 0) {
        unsigned gsel = 0u;
        for (int g = 0; g < 8; ++g) { float m1 = -INFINITY, m2 = -INFINITY; for (int j = 0; j < 8; ++j) { const float x = biased[g * 8 + j]; if (x > m1) { m2 = m1; m1 = x; } else if (x > m2) m2 = x; } gs[g] = m1 + m2; }
        for (int r = 0; r < 4; ++r) { int bi = 0; float bv = -INFINITY; for (int g = 0; g < 8; ++g) if (!((gsel >> g) & 1u) && gs[g] > bv) { bv = gs[g]; bi = g; } gsel |= 1u << bi; }
        float wsum = 0.f;
        for (int r = 0; r < 8; ++r) { int bi = 0; float bv = -INFINITY; for (int e = 0; e < 64; ++e) if (((gsel >> (e >> 3)) & 1u) && biased[e] > bv) { bv = biased[e]; bi = e; } idx[r] = bi; biased[bi] = -INFINITY; wsum += sc[bi]; }
        for (int r = 0; r < 8; ++r) { const int e = idx[r]; const unsigned i = atomicAdd((unsigned*)p.ws + CW_CNT + e, 1u);
            ((int*)(p.ws + WS_ROWS))[e * 8192 + i] = m; ((unsigned*)(p.ws + WS_POS))[m * 8 + r] = ((unsigned)e << 16) | i; ((float*)(p.ws + WS_WTS))[m * 8 + r] = sc[e] / wsum * 2.5f; }
    }
}
__global__ void k_seg(P p) { if (threadIdx.x == 0) { unsigned* w = (unsigned*)p.ws; unsigned s = T; for (int e = 0; e < NE; ++e) { w[CW_SEG + e] = s; s += (w[CW_CNT + e] + 255u) & ~255u; } w[CW_SEG + NE] = 0; } }
__global__ void __launch_bounds__(256) k_final(P p) {
    __shared__ float red[4];
    const int m = blockIdx.x, b = m / SEQ; const float* mod = (const float*)(p.ws + WS_MOD) + b * 12288; const bf16* YS = (const bf16*)(p.ws + WS_YS);
    const unsigned* seg = (const unsigned*)p.ws + CW_SEG; const unsigned* pos = (const unsigned*)(p.ws + WS_POS) + m * 8; const float* wt = (const float*)(p.ws + WS_WTS) + m * 8;
    size_t rows[8]; float w[8];
#pragma unroll
    for (int r = 0; r < 8; ++r) { const unsigned pv = pos[r]; rows[r] = (size_t)(seg[pv >> 16] + (pv & 0xffffu)); w[r] = wt[r]; }
    float v[8]; float ss = 0.f;
#pragma unroll
    for (int j = 0; j < 8; ++j) { const int k = threadIdx.x + 256 * j; float a = bf2f(YS[(size_t)m * D + k]);
#pragma unroll
        for (int r = 0; r < 8; ++r) a += w[r] * bf2f(YS[rows[r] * D + k]);
        v[j] = p.out[(size_t)m * D + k] + mod[5 * 2048 + k] * a; ss += v[j] * v[j]; }
    ss = block_sum256(ss, red); const float rs = rsqrtf(ss * (1.f / D) + EPS);
#pragma unroll
    for (int j = 0; j < 8; ++j) { const int k = threadIdx.x + 256 * j; p.out[(size_t)m * D + k] = v[j] * rs * p.final_g[k]; }
}

extern "C" void kernel_launch(void* const* d_in, const int* in_sizes, int n_in, void* d_out, int out_size, void* d_ws, size_t ws_size, hipStream_t stream) {
    if (n_in != 31 || out_size != T * D || ws_size < WS_END) { fprintf(stderr, "kernel_launch: unexpected sizes n_in %d out %d ws %zu\n", n_in, out_size, ws_size); return; }
    P p{};
    const float** f = (const float**)&p;
    for (int i = 0; i < 31; ++i) f[i] = (const float*)d_in[i];
    p.out = (float*)d_out; p.ws = (unsigned char*)d_ws;
    (void)hipMemsetAsync((char*)d_ws + WS_CTL, 0, CTL_ZERO, stream);
    (void)hipMemsetAsync((char*)d_ws + WS_ROWS, 0, 64 * 8192 * 4, stream);
    k_mod<<<12288 / 64, 256, 0, stream>>>(p);
    k_norm1<<<TR, 256, 0, stream>>>(p);
    k_gemm<FInProj><<<dim3(3072 / 64, TR / 64, 1), 256, 0, stream>>>(p);
    k_ssm<<<dim3(NB, 64, 2), 64, 0, stream>>>(p);
    k_gy<<<T * DS / 256, 256, 0, stream>>>(p);
    k_conv<<<T, 256, 0, stream>>>(p);
    k_gemm<FGlu><<<dim3(1024 / 64, T / 64, 1), 256, 0, stream>>>(p);
    k_gemm<FOut><<<dim3(2048 / 64, T / 64, 1), 256, 0, stream>>>(p);
    k_norm2_route<<<T, 256, 0, stream>>>(p);
    k_seg<<<1, 64, 0, stream>>>(p);
    k_gemm<FAct><<<dim3(512 / 64, T / 64, NE + 1), 256, 0, stream>>>(p);
    k_gemm<FY><<<dim3(2048 / 64, T / 64, NE + 1), 256, 0, stream>>>(p);
    k_final<<<T, 256, 0, stream>>>(p);
}
```

```cpp
#include <hip/hip_runtime.h>
#include <cstdio>
#include <cstdint>

typedef unsigned short bf16;
__device__ __forceinline__ unsigned f2bf(float f) { unsigned u = __builtin_bit_cast(unsigned, f); return (u + 0x7fffu + ((u >> 16) & 1u)) >> 16; }
__device__ __forceinline__ float bf2f(bf16 h) { return __builtin_bit_cast(float, (unsigned)h << 16); }

constexpr int D = 2048, NB = 4, SEQ = 2048, T = NB * SEQ, CTXL = 256, TC = NB * CTXL, TR = T + TC;
constexpr int DS = 1024, NMOD = 6, NE = 64, TOPK = 8, DE = 512;
constexpr float EPS = 1e-6f;
constexpr size_t MiB = 1u << 20;
constexpr size_t WS_CTL = 0, CTL_ZERO = 2 * MiB;
constexpr size_t CW_CNT = 1024;
constexpr size_t WS_MOD = 1 * MiB;
constexpr size_t WS_POS = 2 * MiB;
constexpr size_t WS_WTS = 3 * MiB;
constexpr size_t WS_ROWS = 4 * MiB;
constexpr size_t WS_XN = 8 * MiB;
constexpr size_t WS_U = 44 * MiB;
constexpr size_t WS_BG = 62 * MiB;
constexpr size_t WS_Z = 78 * MiB;
constexpr size_t WS_GY = 94 * MiB;
constexpr size_t WS_HEADS = 110 * MiB;
constexpr size_t WS_ACT = 44 * MiB;
constexpr size_t WS_YS = 142 * MiB;
constexpr size_t WS_END = 912 * MiB;

struct P {
    const float *x, *c, *ctx, *c_ctx, *norm1_g, *norm2_g, *w_ada, *b_ada, *w_in, *lam_re, *lam_im, *b_re, *b_im, *c_re, *c_im, *log_dt,
        *ssm_d, *w_glu, *conv_w, *conv_b, *mix_g, *w_out, *router_w, *router_b, *e_gate, *e_up, *e_down, *s_gate, *s_up, *s_down, *final_g;
    float* out; unsigned char* ws;
};
__device__ __forceinline__ float siluf(float v) { return v / (1.f + __expf(-v)); }
__device__ __forceinline__ float sigmf(float v) { return 1.f / (1.f + __expf(-v)); }
__device__ __forceinline__ float gelu_tanh(float v) { const float u = 0.7978845608028654f * (v + 0.044715f * v * v * v); return 0.5f * v * (1.f + tanhf(u)); }


#define LAS __attribute__((address_space(3)))
#define XB_TMO      128
#define XB_XCNT(j)  (256  + 64 * (j))
#define XB_XSUB(j)  (1280 + 64 * (j))
#define XB_XGEN(j)  (2304 + 64 * (j))
#define XB_TOP      3328
#define XB_TOPGEN   3392
#define XCD_BAR_WORDS 3456
#define XB_SPIN_CAP (1u << 18)
constexpr size_t CW_BAR = 65536;
__device__ __forceinline__ unsigned xb_ld(unsigned* p)              { return __hip_atomic_load(p, __ATOMIC_RELAXED, __HIP_MEMORY_SCOPE_AGENT); }
__device__ __forceinline__ unsigned xb_add(unsigned* p, unsigned v) { return __hip_atomic_fetch_add(p, v, __ATOMIC_RELAXED, __HIP_MEMORY_SCOPE_AGENT); }
__device__ __forceinline__ unsigned xb_xcc_id() { return (unsigned)__builtin_amdgcn_s_getreg((3 << 11) | 20) & 0xFu; }
#define XB_SPIN(cond, bar) do { unsigned _sp = 0; while (cond) { __builtin_amdgcn_s_sleep(1); \
    if ((++_sp & 255u) == 0u) { if (xb_ld(&(bar)[XB_TMO])) break; if (_sp > XB_SPIN_CAP) { atomicAdd(&(bar)[XB_TMO], 1u); break; } } } } while (0)
struct XcdBarrier { unsigned* bar; unsigned x; volatile LAS unsigned* st; };
__device__ __forceinline__ XcdBarrier xcd_barrier_post(unsigned* bar, volatile LAS unsigned* st) {
    XcdBarrier b; b.bar = bar; b.x = xb_xcc_id(); b.st = st;
    if (threadIdx.x == 0) (void)xb_add(&bar[XB_XCNT(b.x)], 1u);
    return b;
}
__device__ __forceinline__ void xcd_barrier_complete(unsigned* bar, unsigned x, unsigned& nloc, unsigned& nx) {
    const unsigned G = gridDim.x * gridDim.y * gridDim.z;
    unsigned sum, cnt, mine, sp = 0u;
    for (;;) {
        sum = 0u; cnt = 0u; mine = 0u;
#pragma unroll
        for (unsigned j = 0; j < 16; ++j) { const unsigned c = xb_ld(&bar[XB_XCNT(j)]); sum += c; cnt += (c > 0u) ? 1u : 0u; mine = (j == x) ? c : mine; }
        if (sum == G) break;
        __builtin_amdgcn_s_sleep(1);
        if ((++sp & 255u) == 0u) { if (xb_ld(&bar[XB_TMO])) break; if (sp > XB_SPIN_CAP) { atomicAdd(&bar[XB_TMO], 1u); break; } }
    }
    nloc = mine > 0u ? mine : 1u; nx = cnt > 0u ? cnt : 1u;
}
__device__ __forceinline__ void xcd_barrier(const XcdBarrier& b) {
    asm volatile("s_waitcnt vmcnt(0)" ::: "memory");
    __syncthreads();
    if (threadIdx.x == 0) {
        unsigned* bar = b.bar;
        __builtin_amdgcn_s_waitcnt(0);
        unsigned nloc = b.st[0], nx = b.st[1];
        if (nloc == 0u) { xcd_barrier_complete(bar, b.x, nloc, nx); b.st[0] = nloc; b.st[1] = nx; }
        const unsigned old = xb_add(&bar[XB_XSUB(b.x)], 1u);
        const unsigned gen = old / nloc;
        if (old + 1u == (gen + 1u) * nloc) {
            __builtin_amdgcn_fence(__ATOMIC_RELEASE, "agent");
            asm volatile("s_waitcnt vmcnt(0)" ::: "memory");
            const unsigned og = xb_add(&bar[XB_TOP], 1u);
            const unsigned tg = og / nx;
            if (og + 1u == (tg + 1u) * nx) xb_add(&bar[XB_TOPGEN], 1u);
            else XB_SPIN(xb_ld(&bar[XB_TOPGEN]) == tg, bar);
            __builtin_amdgcn_fence(__ATOMIC_ACQUIRE, "agent");
            xb_add(&bar[XB_XGEN(b.x)], 1u);
            asm volatile("s_waitcnt vmcnt(0)" ::: "memory");
        } else {
            XB_SPIN(xb_ld(&bar[XB_XGEN(b.x)]) == gen, bar);
            __builtin_amdgcn_fence(__ATOMIC_ACQUIRE, "agent");
            asm volatile("s_waitcnt vmcnt(0)" ::: "memory");
        }
    }
    __syncthreads();
}

namespace pg8 {
#define PG8_LAS __attribute__((address_space(3)))
typedef unsigned short bf16_t;
typedef short bf16x8 __attribute__((ext_vector_type(8)));
typedef float f32x4 __attribute__((ext_vector_type(4)));
typedef unsigned u32x4 __attribute__((ext_vector_type(4)));
constexpr int BM = 256, BK = 64, HALF = 128, HTB = HALF * BK * 2  , STAGE_BYTES = 8 * HTB, NXCD = 8, WGM = 8;

__host__ __device__ __forceinline__ int lds_byte(int r, int c) { const int st = (r >> 4) * 2 + (c >> 5), rr = r & 15, cc = c & 31, ob = rr * 64 + cc * 2; return st * 1024 + (ob ^ (((ob >> 9) & 1) << 5)); }
__host__ __device__ __forceinline__ void stage_rc(int b, int& R, int& C) { const int st = b / 1024, sb = b % 1024, swz = sb ^ (((sb >> 9) & 1) << 5); R = (st >> 1) * 16 + swz / 64; C = (st & 1) * 32 + (swz % 64) / 2; }
__host__ __device__ __forceinline__ int perm32(int rho) { const int n = rho >> 4, i = rho & 15; return 8 * (i >> 2) + 4 * n + (i & 3); }

struct Unit { int pm, pn, e, arow; };

__device__ __forceinline__ void static_tile(int L, int nM, int nN, int& pm, int& pn) {
    const int nwg = nM * nN; int wgid = L; { const int q = nwg / NXCD, r = nwg % NXCD, xcd = wgid % NXCD, off = wgid / NXCD; wgid = (xcd < r ? xcd * (q + 1) : r * (q + 1) + (xcd - r) * q) + off; }
    const int nig = WGM * nN, gid = wgid / nig, fm = gid * WGM, gsz = (nM - fm) < WGM ? (nM - fm) : WGM;
    pm = fm + ((wgid % nig) % gsz); pn = (wgid % nig) / gsz;
}
__device__ __forceinline__ unsigned cvt_pk_bf16(float lo, float hi) { unsigned r; asm volatile("v_cvt_pk_bf16_f32 %0, %1, %2" : "=v"(r) : "v"(lo), "v"(hi)); return r; }

struct ASrc { const char* p; int slot; };
typedef int v8i_t __attribute__((ext_vector_type(8))); typedef int v4i_t __attribute__((ext_vector_type(4)));
__device__ __forceinline__ v8i_t cat32(bf16x8 lo, bf16x8 hi) { const v4i_t a = __builtin_bit_cast(v4i_t, lo), b = __builtin_bit_cast(v4i_t, hi); return __builtin_shufflevector(a, b, 0, 1, 2, 3, 4, 5, 6, 7); }
template <class Epi, class Sched, bool ALIGN_EPI, bool GATHER, bool F8 = false>
__device__ __forceinline__ void gemm_phase(PG8_LAS unsigned char* lds, PG8_LAS unsigned* tab, const int K, const Sched& S, const Epi& E) {
    const int tid = threadIdx.x, wid = __builtin_amdgcn_readfirstlane(tid >> 6), lane = tid & 63, wr = wid >> 2, wc = wid & 3, fr = lane & 15, fq = lane >> 4;
    constexpr int EB = F8 ? 1 : 2;
    const int nt = K * EB / 128;
    unsigned voffA[2], voffB[2]; int RA[2]; unsigned CA2[2];
#pragma unroll
    for (int i = 0; i < 2; ++i) { int R, C; stage_rc(tid * 16 + i * 8192, R, C); const int Rb = Epi::PERM ? ((R & ~31) + perm32(R & 31)) : R;
        voffA[i] = (unsigned)(R * K * EB + C * 2); voffB[i] = (unsigned)(Rb * K * EB + C * 2); RA[i] = R; CA2[i] = (unsigned)C * 2u; }
    const size_t kstep = (size_t)(BK * 2);
    const size_t hstep = (size_t)HALF * K * EB;
    const unsigned ldsw = (unsigned)wid * 1024u;
    const int aoff = F8 ? lds_byte(wr * 64 + fr, fq * 16) : lds_byte(wr * 64 + fr, fq * 8), boff = F8 ? lds_byte(wc * 32 + fr, fq * 16) : lds_byte(wc * 32 + fr, fq * 8);
#define PG8_SA(b, h) (((b) * 2 + (h)) * HTB)
#define PG8_SB(b, h) ((4 + (b) * 2 + (h)) * HTB)
#define PG8_STAGE(bufoff, gbase, voff) do { _Pragma("unroll") for (int _i = 0; _i < 2; ++_i) \
        __builtin_amdgcn_global_load_lds((const unsigned*)((const char*)(gbase) + (voff)[_i]), (PG8_LAS unsigned*)(lds + (bufoff) + ldsw + _i * 8192), 16, 0, 0); } while (0)
#define PG8_STAGE_A(bufoff, src, h) do { if constexpr (GATHER) { _Pragma("unroll") for (int _i = 0; _i < 2; ++_i) { const unsigned _o = tab[(src).slot * 256 + (h) * 128 + RA[_i]] + CA2[_i]; \
        __builtin_amdgcn_global_load_lds((const unsigned*)((src).p + _o), (PG8_LAS unsigned*)(lds + (bufoff) + ldsw + _i * 8192), 16, 0, 0); } } \
        else { PG8_STAGE(bufoff, (src).p + (h) * hstep, voffA); } } while (0)
#define PG8_LDA(dst, b, h) do { if constexpr (F8) { _Pragma("unroll") for (int m = 0; m < 4; ++m) dst##8[m] = cat32(*(const PG8_LAS bf16x8*)(lds + PG8_SA(b, h) + aoff + m * 2048), *(const PG8_LAS bf16x8*)(lds + PG8_SA(b, h) + aoff + m * 2048 + 16)); } \
        else { _Pragma("unroll") for (int m = 0; m < 4; ++m) _Pragma("unroll") for (int k = 0; k < 2; ++k) dst[m][k] = *(const PG8_LAS bf16x8*)(lds + PG8_SA(b, h) + aoff + m * 2048 + k * 1024); } } while (0)
#define PG8_LDB(dst, b, h) do { if constexpr (F8) { _Pragma("unroll") for (int n = 0; n < 2; ++n) dst##8[n] = cat32(*(const PG8_LAS bf16x8*)(lds + PG8_SB(b, h) + boff + n * 2048), *(const PG8_LAS bf16x8*)(lds + PG8_SB(b, h) + boff + n * 2048 + 16)); } \
        else { _Pragma("unroll") for (int n = 0; n < 2; ++n) _Pragma("unroll") for (int k = 0; k < 2; ++k) dst[n][k] = *(const PG8_LAS bf16x8*)(lds + PG8_SB(b, h) + boff + n * 2048 + k * 1024); } } while (0)
#define PG8_MMA(ai, bj, At, Bt) do { __builtin_amdgcn_s_setprio(1); if constexpr (F8) { _Pragma("unroll") for (int m = 0; m < 4; ++m) _Pragma("unroll") for (int n = 0; n < 2; ++n) \
        asm volatile("v_mfma_f32_16x16x128_f8f6f4 %0, %1, %2, %0" : "+v"(acc[ai][bj][m][n]) : "v"(Bt##8[n]), "v"(At##8[m])); }     \
        else { _Pragma("unroll") for (int m = 0; m < 4; ++m) _Pragma("unroll") for (int n = 0; n < 2; ++n) _Pragma("unroll") for (int k = 0; k < 2; ++k) \
        acc[ai][bj][m][n] = __builtin_amdgcn_mfma_f32_16x16x32_bf16(Bt[n][k], At[m][k], acc[ai][bj][m][n], 0, 0, 0); } __builtin_amdgcn_s_setprio(0); } while (0)
#define PG8_WAIT_V(n) asm volatile("s_waitcnt vmcnt(" #n ")" ::: "memory")
#define PG8_WAIT_L(n) asm volatile("s_waitcnt lgkmcnt(" #n ")" ::: "memory")
#define PG8_BAR __builtin_amdgcn_s_barrier()
#define PG8_SCHED __builtin_amdgcn_sched_barrier(0)
    Unit cur, nxt; int ui = 0;
    if (!S.next(0, cur)) return;
    f32x4 acc[2][2][4][2];
#pragma unroll
    for (int a = 0; a < 2; ++a)
#pragma unroll
        for (int b = 0; b < 2; ++b)
#pragma unroll
            for (int m = 0; m < 4; ++m)
#pragma unroll
                for (int n = 0; n < 2; ++n) acc[a][b][m][n] = (f32x4){0.f, 0.f, 0.f, 0.f};
    bf16x8 At[4][2], B0[2][2], B1[2][2];
    v8i_t At8[4], B08[2], B18[2];
    ASrc cA; cA.slot = 0; const char* cB = S.b_ptr(cur);
    if constexpr (GATHER) { cA.p = S.a_base(); S.fill_rows(cur, tab); PG8_WAIT_L(0); PG8_BAR; } else { cA.p = S.a_ptr(cur); }
    {
        ASrc c1 = cA; c1.p += kstep;
        PG8_STAGE(PG8_SB(0, 0), cB, voffB); PG8_STAGE(PG8_SB(0, 1), cB + hstep, voffB); PG8_STAGE_A(PG8_SA(0, 0), cA, 0); PG8_STAGE_A(PG8_SA(0, 1), cA, 1);
        if (wr == 1) PG8_BAR;
        PG8_WAIT_V(2); PG8_BAR;
        PG8_STAGE(PG8_SB(1, 0), cB + kstep, voffB); PG8_STAGE_A(PG8_SA(1, 0), c1, 0); PG8_STAGE(PG8_SB(1, 1), cB + hstep + kstep, voffB);
        PG8_WAIT_V(6); PG8_BAR;
    }
    for (;;) {
        const bool has_next = S.next(ui + 1, nxt);
        ASrc nA = cA; const char* nB = cB;
        if (has_next) { nB = S.b_ptr(nxt); if constexpr (GATHER) { nA.slot = cA.slot ^ 1; S.fill_rows(nxt, tab + nA.slot * 256); } else { nA.p = S.a_ptr(nxt); } }
        for (int t = 0; t < nt; t += 2) {
            const bool last = (t == nt - 2);
            if constexpr (Epi::MIDK) { if (t == nt / 2) E.midk(acc, cur, wr, fr); }
            ASrc a1 = cA; a1.p += (size_t)(t + 1) * kstep;
            ASrc a2 = cA; a2.p += (size_t)(t + 2) * kstep; if (last) a2 = nA;
            const char* b2 = last ? nB : cB + (size_t)(t + 2) * kstep;
            ASrc a3 = a2; a3.p += kstep; const char* b3 = b2 + kstep;
            PG8_LDB(B0, 0, 0); PG8_LDB(B1, 0, 1); PG8_SCHED; PG8_LDA(At, 0, 0); PG8_STAGE_A(PG8_SA(1, 1), a1, 1);
            PG8_WAIT_V(8); PG8_WAIT_L(0); PG8_BAR; PG8_MMA(0, 0, At, B0); PG8_MMA(0, 1, At, B1); PG8_BAR; PG8_SCHED;
            PG8_LDA(At, 0, 1); PG8_STAGE(PG8_SB(0, 0), b2, voffB); PG8_STAGE(PG8_SB(0, 1), b2 + hstep, voffB); PG8_STAGE_A(PG8_SA(0, 0), a2, 0);
            PG8_WAIT_V(8); PG8_WAIT_L(0); PG8_BAR; PG8_MMA(1, 0, At, B0); PG8_MMA(1, 1, At, B1); PG8_BAR; PG8_SCHED;
            PG8_LDB(B0, 1, 0); PG8_LDB(B1, 1, 1); PG8_SCHED; PG8_LDA(At, 1, 0); PG8_STAGE_A(PG8_SA(0, 1), a2, 1);
            PG8_WAIT_V(8); PG8_WAIT_L(0); PG8_BAR; PG8_MMA(0, 0, At, B0); PG8_MMA(0, 1, At, B1); PG8_BAR; PG8_SCHED;
            PG8_LDA(At, 1, 1); PG8_STAGE(PG8_SB(1, 0), b3, voffB); PG8_STAGE(PG8_SB(1, 1), b3 + hstep, voffB); PG8_STAGE_A(PG8_SA(1, 0), a3, 0);
            PG8_WAIT_V(8); PG8_WAIT_L(0); PG8_BAR; PG8_MMA(1, 0, At, B0); PG8_MMA(1, 1, At, B1); PG8_BAR; PG8_SCHED;
        }
        if constexpr (ALIGN_EPI) { if (wr == 0) PG8_BAR; }
        if constexpr (F8) asm volatile("s_nop 15\n\ts_nop 15" ::: "memory");
        if constexpr (Epi::DRAIN) { if (has_next) E(acc, cur, wr, wc, fr, fq); } else E(acc, cur, wr, wc, fr, fq);
        if (!has_next) break;
#pragma unroll
        for (int a = 0; a < 2; ++a)
#pragma unroll
            for (int b = 0; b < 2; ++b)
#pragma unroll
                for (int m = 0; m < 4; ++m)
#pragma unroll
                    for (int n = 0; n < 2; ++n) acc[a][b][m][n] = (f32x4){0.f, 0.f, 0.f, 0.f};
        cur = nxt; cA = nA; cB = nB; ++ui;
        if constexpr (ALIGN_EPI) { if (wr == 1) PG8_BAR; }
    }
    PG8_WAIT_V(0);
    if constexpr (!ALIGN_EPI) { if (wr == 0) PG8_BAR; }
    PG8_BAR;
    if constexpr (Epi::DRAIN) E.fused(acc, cur, wr, wc, fr, fq, lds);
#undef PG8_SA
#undef PG8_SB
#undef PG8_STAGE
#undef PG8_STAGE_A
#undef PG8_LDA
#undef PG8_LDB
#undef PG8_MMA
#undef PG8_WAIT_V
#undef PG8_WAIT_L
#undef PG8_BAR
#undef PG8_SCHED
}
}
constexpr int NWAVES = 8;
constexpr size_t WS_WRT_HI = 2 * MiB + 256 * 1024, WS_WRT_LO = 2 * MiB + 512 * 1024;
constexpr size_t WS_XN8 = WS_XN;
constexpr size_t WS_RSP_SSM = 6 * MiB, WS_RSP_X1 = 7 * MiB;
constexpr size_t WS_WIN_T = 494 * MiB;
constexpr size_t WS_WGLU_T = 510 * MiB;
constexpr size_t WS_WOUT_T = 514 * MiB;
constexpr size_t WS_WS1_T = 522 * MiB;
constexpr size_t WS_WS2_T = 526 * MiB;
constexpr size_t WS_WE1_T = 528 * MiB;
constexpr size_t WS_WE2_T = 784 * MiB;
static_assert(WS_WE2_T + 64 * 2 * MiB == WS_END, "ws map");
constexpr int RING_BYTES = 131072, MISC_OFF = 155 * 1024, LDS_BYTES = 160 * 1024;
constexpr int MW_BAR = 0, MW_TILES = 16, MW_UPRE = 96, MW_SEG = 176, MW_TAB = 256, MW_CAP = 768, MW_SBASE = 848;
typedef pg8::f32x4 f32x4; typedef pg8::u32x4 u32x4;
typedef unsigned u32x2 __attribute__((ext_vector_type(2)));
typedef short bf16x8v __attribute__((ext_vector_type(8)));

struct Fr { LAS unsigned char* lds; volatile LAS unsigned* misc; int tid, lane, wave, G, bid; };

struct SDense {
    const char* A; const char* Bt; int nM, nN, extra, exN, K, G, c;
    __device__ __forceinline__ bool next(int i, pg8::Unit& u) const { const int L = i * G + c, nwg = nM * nN; if (L >= nwg + extra) return false;
        if (L < nwg) pg8::static_tile(L, nM, nN, u.pm, u.pn); else { const int r = L - nwg; u.pm = nM + r / exN; u.pn = r % exN; } u.e = 0; u.arow = u.pm * 256; return true; }
    __device__ __forceinline__ const char* a_ptr(const pg8::Unit& u) const { return A + (size_t)u.pm * 256 * K * 2; }
    __device__ __forceinline__ const char* b_ptr(const pg8::Unit& u) const { return Bt + (size_t)u.pn * 256 * K * 2; }
};
template <int NPN, bool PN_OUTER> struct SMoe {
    const volatile LAS unsigned* misc; const unsigned char* ws; int K, G, c;
    __device__ __forceinline__ bool next(int i, pg8::Unit& u) const {
        const int ntot = (int)misc[MW_UPRE + 65] * NPN, chunk = (ntot + 7) >> 3, x = c & 7, j = c >> 3, w = i * 32 + j;
        const int L = x * chunk + w; if (w >= chunk || L >= ntot) return false;
        int gi = 0;
        for (int s = 64; s > 0; s >>= 1) { const int t = gi + s; if (t <= 64 && (int)misc[MW_UPRE + t] * NPN <= L) gi = t; }
        const int rem = L - (int)misc[MW_UPRE + gi] * NPN, tl = (int)misc[MW_TILES + gi];
        if (PN_OUTER) { u.pn = rem / tl; u.pm = rem % tl; } else { u.pm = rem / NPN; u.pn = rem % NPN; }
        u.e = gi; u.arow = (int)misc[MW_SEG + gi] + u.pm * 256; return true; }
    __device__ __forceinline__ const char* a_base() const { return (const char*)(ws + WS_XN8); }
    __device__ __forceinline__ void fill_rows(const pg8::Unit& u, LAS unsigned* slot) const { const int t = threadIdx.x;
        if (t < 256) { const unsigned tok = u.e < 64 ? (unsigned)((const int*)(ws + WS_ROWS))[u.e * 8192 + u.pm * 256 + t] : (unsigned)(u.pm * 256 + t); slot[t] = tok * (unsigned)D; } }
    __device__ __forceinline__ const char* a_ptr(const pg8::Unit& u) const { return (const char*)(ws + WS_ACT) + (size_t)u.arow * K; }
    __device__ __forceinline__ const char* b_ptr(const pg8::Unit& u) const {
        if (NPN == 4) return (const char*)(ws + (u.e < 64 ? WS_WE1_T + (size_t)u.e * 4 * MiB : WS_WS1_T)) + (size_t)u.pn * 256 * K;
        return (const char*)(ws + (u.e < 64 ? WS_WE2_T + (size_t)u.e * 2 * MiB : WS_WS2_T)) + (size_t)u.pn * 256 * K; }
};

__device__ __forceinline__ u32x4 pack8(const f32x4 a, const f32x4 b) { u32x4 w; w.x = pg8::cvt_pk_bf16(a[0], a[1]); w.y = pg8::cvt_pk_bf16(a[2], a[3]); w.z = pg8::cvt_pk_bf16(b[0], b[1]); w.w = pg8::cvt_pk_bf16(b[2], b[3]); return w; }
__device__ __forceinline__ float gelu_fast(float v) { const float u2 = 1.5957691216057308f * (v + 0.044715f * v * v * v); return v * __builtin_amdgcn_rcpf(1.f + __expf(-u2)); }
__device__ __forceinline__ float clamp8(float v) { return __builtin_amdgcn_fmed3f(v, -440.f, 440.f); }
__device__ __forceinline__ unsigned pk4_fp8(float a, float b, float c, float d) { a = clamp8(a); b = clamp8(b); c = clamp8(c); d = clamp8(d); int w = 0; w = __builtin_amdgcn_cvt_pk_fp8_f32(a, b, w, false); w = __builtin_amdgcn_cvt_pk_fp8_f32(c, d, w, true); return (unsigned)w; }
__device__ __forceinline__ float fsig(float v) { return __builtin_amdgcn_rcpf(1.f + __expf(-v)); }
struct EpiInProj { static constexpr bool PERM = true, MIDK = false, DRAIN = false;
    bf16 *U, *BG, *Z;
    __device__ __forceinline__ void operator()(const f32x4 (&acc)[2][2][4][2], const pg8::Unit& u, int wr, int wc, int fr, int fq) const {
        const int row0 = u.pm * 256 + wr * 64 + fr, cw = wc * 32 + 8 * fq;
        if (u.pn < 8) { bf16* O = (u.pn < 4 ? U : BG) + (u.pn & 3) * 256 + cw;
#pragma unroll
            for (int ai = 0; ai < 2; ++ai)
#pragma unroll
                for (int m = 0; m < 4; ++m) { bf16* rp = O + (size_t)(row0 + ai * 128 + m * 16) * DS;
#pragma unroll
                    for (int bj = 0; bj < 2; ++bj) *(u32x4*)(rp + bj * 128) = pack8(acc[ai][bj][m][0], acc[ai][bj][m][1]); }
        } else { bf16* O = Z + (u.pn - 8) * 128 + cw;
#pragma unroll
            for (int ai = 0; ai < 2; ++ai)
#pragma unroll
                for (int m = 0; m < 4; ++m) *(u32x4*)(O + (size_t)(row0 + ai * 128 + m * 16) * DS) = pack8(acc[ai][0][m][0] * acc[ai][1][m][0], acc[ai][0][m][1] * acc[ai][1][m][1]); }
    }
};
struct EpiGlu { static constexpr bool PERM = true, MIDK = false, DRAIN = false;
    bf16* HEADS; const float* mix_g; float* rs;
    __device__ __forceinline__ void operator()(const f32x4 (&acc)[2][2][4][2], const pg8::Unit& u, int wr, int wc, int fr, int fq) const {
        const int row0 = u.pm * 256 + wr * 64 + fr, col = u.pn * 128 + wc * 32 + 8 * fq;
        const f32x4 g0 = *(const f32x4*)(mix_g + col), g1 = *(const f32x4*)(mix_g + col + 4);
#pragma unroll
        for (int ai = 0; ai < 2; ++ai)
#pragma unroll
            for (int m = 0; m < 4; ++m) { const int row = row0 + ai * 128 + m * 16; f32x4 s0, s1; float ss = 0.f;
#pragma unroll
                for (int e = 0; e < 4; ++e) { s0[e] = acc[ai][0][m][0][e] * fsig(acc[ai][1][m][0][e]); s1[e] = acc[ai][0][m][1][e] * fsig(acc[ai][1][m][1][e]); ss += s0[e] * s0[e] + s1[e] * s1[e]; }
                ss += __shfl_xor(ss, 16); ss += __shfl_xor(ss, 32);
                if (fq == 0) rs[row * 32 + u.pn * 4 + wc] = ss;
                *(u32x4*)(HEADS + (size_t)row * D + col) = pack8(s0 * g0, s1 * g1); }
    }
};
struct EpiOut { static constexpr bool PERM = false, MIDK = true, DRAIN = true;
    const float* x; float* x1; const float* mod; const float* rs_ssm; float* rs_x1;
    __device__ __forceinline__ void midk(f32x4 (&acc)[2][2][4][2], const pg8::Unit& u, int wr, int fr) const {
#pragma unroll
        for (int ai = 0; ai < 2; ++ai)
#pragma unroll
            for (int m = 0; m < 4; ++m) { const f32x4* pr = (const f32x4*)(rs_ssm + (size_t)(u.pm * 256 + ai * 128 + wr * 64 + m * 16 + fr) * 32); f32x4 s4 = pr[0];
#pragma unroll
                for (int j = 1; j < 8; ++j) s4 += pr[j];
                const float f = rsqrtf(((s4[0] + s4[1]) + (s4[2] + s4[3])) * (1.f / 1024.f) + EPS);
#pragma unroll
                for (int bj = 0; bj < 2; ++bj)
#pragma unroll
                    for (int n = 0; n < 2; ++n) acc[ai][bj][m][n] *= f; }
    }
    __device__ __forceinline__ void operator()(const f32x4 (&acc)[2][2][4][2], const pg8::Unit& u, int wr, int wc, int fr, int fq) const {
        const int row0 = u.pm * 256 + wr * 64 + fr, col0 = u.pn * 256 + wc * 32 + 4 * fq; const float* g1 = mod + (u.pm >> 3) * 12288 + 2 * 2048;
#pragma unroll
        for (int ai = 0; ai < 2; ++ai)
#pragma unroll
            for (int m = 0; m < 4; ++m) { const int row = row0 + ai * 128 + m * 16; float ss = 0.f;
#pragma unroll
                for (int bj = 0; bj < 2; ++bj)
#pragma unroll
                    for (int n = 0; n < 2; ++n) { const int col = col0 + bj * 128 + n * 16; const f32x4 xv = __builtin_nontemporal_load((const f32x4*)(x + (size_t)row * D + col)), gv = *(const f32x4*)(g1 + col);
                        const f32x4 o = xv + gv * acc[ai][bj][m][n]; ss += (o[0] * o[0] + o[1] * o[1]) + (o[2] * o[2] + o[3] * o[3]); *(f32x4*)(x1 + (size_t)row * D + col) = o; }
                ss += __shfl_xor(ss, 16); ss += __shfl_xor(ss, 32);
                if (fq == 0) rs_x1[row * 32 + u.pn * 4 + wc] = ss; }
    }
    __device__ __forceinline__ void fused(const f32x4 (&acc)[2][2][4][2], const pg8::Unit& u, int wr, int wc, int fr, int fq, LAS unsigned char* lds) const {
        const int tid = threadIdx.x, lane = tid & 63, col0 = u.pn * 256 + wc * 32 + 4 * fq; const float* g1 = mod + (u.pm >> 3) * 12288 + 2 * 2048;
        f32x4 gv[2][2];
#pragma unroll
        for (int bj = 0; bj < 2; ++bj)
#pragma unroll
            for (int n = 0; n < 2; ++n) gv[bj][n] = *(const f32x4*)(g1 + col0 + bj * 128 + n * 16);
#pragma unroll 1
        for (int ai = 0; ai < 2; ++ai) {
#pragma unroll
            for (int i = 0; i < 16; ++i) { const int r = (tid >> 6) + 8 * i, c = lane ^ (r & 15);
                __builtin_amdgcn_global_load_lds((const unsigned*)(x + (size_t)(u.pm * 256 + ai * 128 + r) * D + u.pn * 256 + c * 4), (LAS unsigned*)(lds + ((tid & ~63) + 512 * i) * 16), 16, 0, 2); }
            asm volatile("s_waitcnt vmcnt(0)" ::: "memory"); __builtin_amdgcn_s_barrier(); asm volatile("" ::: "memory");
#pragma unroll
            for (int m = 0; m < 4; ++m) { const int rl = wr * 64 + m * 16 + fr, row = u.pm * 256 + ai * 128 + rl; float ss = 0.f;
#pragma unroll
                for (int bj = 0; bj < 2; ++bj)
#pragma unroll
                    for (int n = 0; n < 2; ++n) { const int col = col0 + bj * 128 + n * 16, slot = (bj * 32 + wc * 8 + n * 4 + fq) ^ (rl & 15);
                        const f32x4 xv = *(const LAS f32x4*)(lds + (rl * 64 + slot) * 16);
                        const f32x4 a = ai == 0 ? acc[0][bj][m][n] : acc[1][bj][m][n];
                        const f32x4 o = xv + gv[bj][n] * a; ss += (o[0] * o[0] + o[1] * o[1]) + (o[2] * o[2] + o[3] * o[3]); *(f32x4*)(x1 + (size_t)row * D + col) = o; }
                ss += __shfl_xor(ss, 16); ss += __shfl_xor(ss, 32);
                if (fq == 0) rs_x1[row * 32 + u.pn * 4 + wc] = ss; }
            asm volatile("s_waitcnt lgkmcnt(0)" ::: "memory"); __builtin_amdgcn_s_barrier(); asm volatile("" ::: "memory");
        }
    }
};
struct EpiAct { static constexpr bool PERM = true, MIDK = false, DRAIN = false;
    unsigned char* ACT;
    __device__ __forceinline__ void operator()(const f32x4 (&acc)[2][2][4][2], const pg8::Unit& u, int wr, int wc, int fr, int fq) const {
        unsigned char* O = ACT + (size_t)(u.arow + wr * 64 + fr) * DE + u.pn * 128 + wc * 32 + 8 * fq;
#pragma unroll
        for (int ai = 0; ai < 2; ++ai)
#pragma unroll
            for (int m = 0; m < 4; ++m) { f32x4 s0, s1;
#pragma unroll
                for (int e = 0; e < 4; ++e) { const float g0 = acc[ai][0][m][0][e] * 0.00390625f, g1 = acc[ai][0][m][1][e] * 0.00390625f;
                    s0[e] = 0.0625f * g0 * fsig(g0) * acc[ai][1][m][0][e]; s1[e] = 0.0625f * g1 * fsig(g1) * acc[ai][1][m][1][e]; }
                u32x2 o; o.x = pk4_fp8(s0[0], s0[1], s0[2], s0[3]); o.y = pk4_fp8(s1[0], s1[1], s1[2], s1[3]);
                *(u32x2*)(O + (size_t)(ai * 128 + m * 16) * DE) = o; }
    }
};
struct EpiY { static constexpr bool PERM = true, MIDK = false, DRAIN = false;
    unsigned char* YS;
    __device__ __forceinline__ void operator()(const f32x4 (&acc)[2][2][4][2], const pg8::Unit& u, int wr, int wc, int fr, int fq) const {
        unsigned char* O = YS + (size_t)(u.arow + wr * 64 + fr) * D + (u.pn * 16 + wc * 4 + fq) * 16;
#pragma unroll
        for (int ai = 0; ai < 2; ++ai)
#pragma unroll
            for (int m = 0; m < 4; ++m) { const f32x4 a0 = acc[ai][0][m][0] * 0.0625f, a1 = acc[ai][0][m][1] * 0.0625f, b0 = acc[ai][1][m][0] * 0.0625f, b1 = acc[ai][1][m][1] * 0.0625f;
                u32x4 o; o.x = pk4_fp8(a0[0], a0[1], a0[2], a0[3]); o.y = pk4_fp8(a1[0], a1[1], a1[2], a1[3]); o.z = pk4_fp8(b0[0], b0[1], b0[2], b0[3]); o.w = pk4_fp8(b1[0], b1[1], b1[2], b1[3]);
                __builtin_nontemporal_store(o, (u32x4*)(O + (size_t)(ai * 128 + m * 16) * D)); }
    }
};

__device__ __forceinline__ unsigned pk2(float lo, float hi) { return f2bf(lo) | (f2bf(hi) << 16); }
struct CvItem { const float* W; bf16* WT; int K, N, k0, n0, rowbase, f8; };
__device__ __forceinline__ int pair_row(int n, int half) { return 256 * (n >> 7) + 128 * half + (n & 127); }
constexpr int CV_IN = 32 * 128, CV_GLU = 16 * 64, CV_OUT = 32 * 64, CV_S = 512, CV_E = 512;
constexpr int CV_TOTAL = CV_IN + CV_GLU + CV_OUT + 3 * CV_S + 64 * 3 * CV_E;
__device__ __forceinline__ CvItem cv_decode(const P& p, int it) {
    unsigned char* ws = p.ws; CvItem c;
    if (it < CV_IN) { const int kb = it / 128, nb = it % 128, n0 = nb * 32; int rb; if (n0 < 2048) rb = n0; else if (n0 < 3072) rb = 2048 + pair_row(n0 - 2048, 0); else rb = 2048 + pair_row(n0 - 3072, 1);
        c.W = p.w_in; c.WT = (bf16*)(ws + WS_WIN_T); c.K = 2048; c.N = 4096; c.k0 = kb * 64; c.n0 = n0; c.rowbase = rb; c.f8 = 0; return c; }
    it -= CV_IN;
    if (it < CV_GLU) { const int kb = it / 64, nb = it % 64, n0 = nb * 32;
        c.W = p.w_glu; c.WT = (bf16*)(ws + WS_WGLU_T); c.K = 1024; c.N = 2048; c.k0 = kb * 64; c.n0 = n0; c.rowbase = n0 < 1024 ? pair_row(n0, 0) : pair_row(n0 - 1024, 1); c.f8 = 0; return c; }
    it -= CV_GLU;
    if (it < CV_OUT) { const int kb = it / 64, nb = it % 64; c.W = p.w_out; c.WT = (bf16*)(ws + WS_WOUT_T); c.K = 2048; c.N = 2048; c.k0 = kb * 64; c.n0 = nb * 32; c.rowbase = nb * 32; c.f8 = 0; return c; }
    it -= CV_OUT;
    int e = 64;
    if (it >= 3 * CV_S) { it -= 3 * CV_S; e = it / (3 * CV_E); it -= e * 3 * CV_E; }
    const int which = it / 512, r = it % 512;
    if (which < 2) { c.W = e < 64 ? (which == 0 ? p.e_gate : p.e_up) + (size_t)e * D * DE : (which == 0 ? p.s_gate : p.s_up);
        c.WT = (bf16*)(ws + (e < 64 ? WS_WE1_T + (size_t)e * 4 * MiB : WS_WS1_T)); const int kb = r / 16, nb = r % 16;
        c.K = 2048; c.N = 512; c.k0 = kb * 64; c.n0 = nb * 32; c.rowbase = pair_row(nb * 32, which);
    } else { c.W = e < 64 ? p.e_down + (size_t)e * DE * D : p.s_down; c.WT = (bf16*)(ws + (e < 64 ? WS_WE2_T + (size_t)e * 2 * MiB : WS_WS2_T)); const int kb = r / 64, nb = r % 64;
        c.K = 512; c.N = 2048; c.k0 = kb * 64; c.n0 = nb * 32; c.rowbase = nb * 32; }
    c.f8 = 1;
    return c;
}
__device__ __forceinline__ void cv_load(const CvItem& c, float (&r)[32], int lane) {
    const float* src = c.W + (size_t)(c.k0 + (lane >> 5)) * c.N + c.n0 + (lane & 31);
#pragma unroll
    for (int i = 0; i < 32; ++i) r[i] = __builtin_nontemporal_load(src + (size_t)(2 * i) * c.N);
}
__device__ __forceinline__ void cv_finish(const CvItem& c, const float (&r)[32], LAS float* scr, int lane) {
#pragma unroll
    for (int i = 0; i < 32; ++i) scr[(2 * i + (lane >> 5)) * 33 + (lane & 31)] = r[i];
    asm volatile("s_waitcnt lgkmcnt(0)" ::: "memory");
    const int cc = lane & 7;
#pragma unroll
    for (int j = 0; j < 4; ++j) { const int n = (lane >> 3) + 8 * j; const LAS float* s = scr + (8 * cc) * 33 + n;
        if (c.f8) { u32x2 o; o.x = pk4_fp8(16.f * s[0 * 33], 16.f * s[1 * 33], 16.f * s[2 * 33], 16.f * s[3 * 33]); o.y = pk4_fp8(16.f * s[4 * 33], 16.f * s[5 * 33], 16.f * s[6 * 33], 16.f * s[7 * 33]);
            *(u32x2*)((unsigned char*)c.WT + (size_t)(c.rowbase + n) * c.K + c.k0 + 8 * cc) = o; }
        else { u32x4 o; o.x = pg8::cvt_pk_bf16(s[0 * 33], s[1 * 33]); o.y = pg8::cvt_pk_bf16(s[2 * 33], s[3 * 33]); o.z = pg8::cvt_pk_bf16(s[4 * 33], s[5 * 33]); o.w = pg8::cvt_pk_bf16(s[6 * 33], s[7 * 33]);
            *(u32x4*)(c.WT + (size_t)(c.rowbase + n) * c.K + c.k0 + 8 * cc) = o; } }
    asm volatile("s_waitcnt lgkmcnt(0)" ::: "memory");
}

constexpr int CVB_E = 768;
constexpr int CVS_UP = 65 * 512, CVS_DOWN = 65 * 256;
struct CvBig { const float* src; unsigned char* dst; int N, K; };
__device__ __forceinline__ CvBig cvb_decode(const P& p, int set, int j, int lane) {
    unsigned char* ws = p.ws; const int e = set == 0 ? j >> 9 : j >> 8, which = set == 0 ? (j >> 8) & 1 : 2, s = j & 255;
    const float* W; unsigned char* WT; int K, N, k0, n0, rowbase;
    if (which < 2) { W = e < 64 ? (which == 0 ? p.e_gate : p.e_up) + (size_t)e * D * DE : (which == 0 ? p.s_gate : p.s_up); WT = ws + (e < 64 ? WS_WE1_T + (size_t)e * 4 * MiB : WS_WS1_T);
        K = 2048; N = 512; k0 = (s >> 4) * 128; n0 = (s & 15) * 32; rowbase = pair_row(n0, which); }
    else { W = e < 64 ? p.e_down + (size_t)e * DE * D : p.s_down; WT = ws + (e < 64 ? WS_WE2_T + (size_t)e * 2 * MiB : WS_WS2_T); K = 512; N = 2048; k0 = (s >> 6) * 128; n0 = (s & 63) * 32; rowbase = n0; }
    CvBig c; c.src = W + (size_t)(k0 + (lane >> 3)) * N + n0 + 4 * (lane & 7); c.dst = WT + (size_t)(rowbase + (lane >> 3)) * K + k0 + 16 * (lane & 7); c.N = N; c.K = K; return c;
}
__device__ __forceinline__ void cvb_load(const CvBig& c, f32x4 (&rr)[16]) {
#pragma unroll
    for (int i = 0; i < 16; ++i) rr[i] = __builtin_nontemporal_load((const f32x4*)(c.src + (size_t)(8 * i) * c.N));
}
__device__ __forceinline__ void cvb_finish(const CvBig& c, const f32x4 (&rr)[16], LAS float* scr, int lane) {
#pragma unroll
    for (int i = 0; i < 16; ++i) { LAS float* d = scr + (8 * i + (lane >> 3)) * 33 + 4 * (lane & 7); d[0] = rr[i][0]; d[1] = rr[i][1]; d[2] = rr[i][2]; d[3] = rr[i][3]; }
    asm volatile("s_waitcnt lgkmcnt(0)" ::: "memory");
    const int cc = lane & 7;
#pragma unroll
    for (int j = 0; j < 4; ++j) { const int n = (lane >> 3) + 8 * j; const LAS float* sp = scr + (16 * cc) * 33 + n; u32x4 o;
#pragma unroll
        for (int d = 0; d < 4; ++d) o[d] = pk4_fp8(16.f * sp[(4 * d) * 33], 16.f * sp[(4 * d + 1) * 33], 16.f * sp[(4 * d + 2) * 33], 16.f * sp[(4 * d + 3) * 33]);
        __builtin_nontemporal_store(o, (u32x4*)(c.dst + (size_t)(8 * j) * c.K)); }
    asm volatile("s_waitcnt lgkmcnt(0)" ::: "memory");
}
__device__ __forceinline__ float wave_sum(float v) {
#pragma unroll
    for (int o = 1; o < 64; o <<= 1) v += __shfl_xor(v, o);
    return v;
}
__device__ __forceinline__ void norm1_load(const P& p, int r, int lane, f32x4 (&v)[8]) {
    const float* src = r < T ? p.x + (size_t)r * D : p.ctx + (size_t)(r - T) * D;
#pragma unroll
    for (int j = 0; j < 8; ++j) v[j] = __builtin_nontemporal_load((const f32x4*)(src + 4 * lane + 256 * j));
}
__device__ __forceinline__ void norm1_finish(const P& p, int r, int lane, const f32x4 (&v)[8], const LAS float* GT) {
    float ss = 0.f;
#pragma unroll
    for (int j = 0; j < 8; ++j) ss += (v[j][0] * v[j][0] + v[j][1] * v[j][1]) + (v[j][2] * v[j][2] + v[j][3] * v[j][3]);
    const float rs = rsqrtf(wave_sum(ss) * (1.f / D) + EPS);
    const LAS float* gt = GT + (r < T ? r / SEQ : 4) * 4096;
    bf16* o = (bf16*)(p.ws + WS_XN) + (size_t)r * D;
#pragma unroll
    for (int j = 0; j < 8; ++j) { const int k = 4 * lane + 256 * j; const f32x4 g = *(const LAS f32x4*)(gt + k), sh = *(const LAS f32x4*)(gt + 2048 + k);
        const f32x4 y = (v[j] * rs) * g + sh; u32x2 w; w.x = pk2(y[0], y[1]); w.y = pk2(y[2], y[3]); *(u32x2*)(o + k) = w; }
}
__device__ __forceinline__ void ph_pre(const P& p, const Fr& F) {
    LAS float* scr = (LAS float*)(F.lds + F.wave * 16896);
    constexpr int CV_SMALL = CV_IN + CV_GLU + CV_OUT;
    const int gw = F.bid * NWAVES + F.wave, NGW = F.G * NWAVES;
    LAS float* GT = (LAS float*)F.lds;
    { const f32x4 g = *(const f32x4*)(p.norm1_g + 4 * F.tid); f32x4 sc[5], sh[5];
#pragma unroll
      for (int j = 0; j < 5; ++j) { const float* mod = (const float*)(p.ws + WS_MOD) + j * 12288; sc[j] = *(const f32x4*)(mod + 2048 + 4 * F.tid); sh[j] = *(const f32x4*)(mod + 4 * F.tid); }
#pragma unroll
      for (int j = 0; j < 5; ++j) { *(LAS f32x4*)(GT + j * 4096 + 4 * F.tid) = g * (1.f + sc[j]); *(LAS f32x4*)(GT + j * 4096 + 2048 + 4 * F.tid) = sh[j]; } }
    __syncthreads();
    { int r = gw; f32x4 v[8], vn[8];
      if (r < TR) norm1_load(p, r, F.lane, v);
      while (r < TR) { const int rn = r + NGW; if (rn < TR) norm1_load(p, rn, F.lane, vn);
          norm1_finish(p, r, F.lane, v, GT);
#pragma unroll
          for (int j = 0; j < 8; ++j) v[j] = vn[j];
          r = rn; } }
    __syncthreads();
    for (int i = gw * 64 + F.lane; i < NE * D; i += NGW * 64) { const int e = i >> 11, k = i & 2047; const float w = p.router_w[(size_t)k * NE + e]; const unsigned h = f2bf(w);
        const int fi = (((((k >> 8) * 8 + ((k >> 5) & 7)) * 2 + (e >> 5)) * 2 + ((k >> 3) & 1)) * 64 + ((k >> 4) & 1) * 32 + (e & 31)) * 8 + (k & 7);
        ((bf16*)(p.ws + WS_WRT_HI))[fi] = (bf16)h; ((bf16*)(p.ws + WS_WRT_LO))[fi] = (bf16)f2bf(w - __builtin_bit_cast(float, h << 16)); }
    { float ra[32], rb[32]; int it = gw;
      if (it < CV_SMALL) { CvItem ca = cv_decode(p, it); cv_load(ca, ra, F.lane);
        for (;;) { const int itb = it + NGW; CvItem cb; const bool hb = itb < CV_SMALL; if (hb) { cb = cv_decode(p, itb); cv_load(cb, rb, F.lane); }
            cv_finish(ca, ra, scr, F.lane); if (!hb) break;
            const int itc = itb + NGW; const bool hc = itc < CV_SMALL; if (hc) { ca = cv_decode(p, itc); cv_load(ca, ra, F.lane); }
            cv_finish(cb, rb, scr, F.lane); if (!hc) break; it = itc; } } }
}

__device__ __forceinline__ void conv_slice(const P& p, const Fr& F, int set, int first, int hi, int st) {
    LAS float* scr = (LAS float*)(F.lds + F.wave * 16896);
    __syncthreads();
    { int j = first + F.wave; f32x4 ra[16], rb[16];
      if (j < hi) { CvBig ca = cvb_decode(p, set, j, F.lane); cvb_load(ca, ra);
        for (;;) { CvBig cb; const bool hb = j + st < hi; if (hb) { cb = cvb_decode(p, set, j + st, F.lane); cvb_load(cb, rb); }
            cvb_finish(ca, ra, scr, F.lane); if (!hb) break;
            const bool hc = j + 2 * st < hi; if (hc) { ca = cvb_decode(p, set, j + 2 * st, F.lane); cvb_load(ca, ra); }
            cvb_finish(cb, rb, scr, F.lane); if (!hc) break; j += 2 * st; } } }
    __syncthreads();
}
__device__ __forceinline__ int wave_excl_scan(int v, int lane) {
    int s = v;
#pragma unroll
    for (int o = 1; o < 64; o <<= 1) { const int t = __shfl_up(s, o); if (lane >= o) s += t; }
    return s - v;
}
__device__ __forceinline__ void moe_tables(const P& p, const Fr& F, const int ppc = 1) {
    if (F.wave == 0) { const int e = F.lane; const unsigned* cnt = (const unsigned*)p.ws + CW_CNT;
        const int tl = (int)((xb_ld((unsigned*)cnt + e) + 255u) >> 8); const int up = wave_excl_scan(tl, e); const int tot = __shfl(up + tl, 63);
        F.misc[MW_TILES + e] = (unsigned)tl; F.misc[MW_UPRE + e] = (unsigned)up; F.misc[MW_SEG + e] = (unsigned)(T + up * 256);
        const int npn = 4 * ppc, total = (tot + 32) * npn, tgt = (total + F.G - 1) / F.G; const int r = tl * ppc, cap = tgt > r ? tgt - r : 0; const int sb = wave_excl_scan(4 * cap, e);
        F.misc[MW_CAP + e] = (unsigned)cap; F.misc[MW_SBASE + e] = (unsigned)sb;
        if (e == 63) { F.misc[MW_TILES + 64] = 32u; F.misc[MW_UPRE + 64] = (unsigned)tot; F.misc[MW_SEG + 64] = 0u; F.misc[MW_UPRE + 65] = (unsigned)(tot + 32); F.misc[MW_SBASE + 64] = (unsigned)(sb + 4 * cap); } }
    __syncthreads();
}


__device__ __forceinline__ void ph_mod(const P& p, const Fr& F) {
    LAS float* sv = (LAS float*)F.lds;
    LAS float* red = (LAS float*)(F.lds + 43008);
    float* mod = (float*)(p.ws + WS_MOD);
    const int vcu = (F.G % 8 == 0) ? (F.bid & 7) * (F.G / 8) + (F.bid >> 3) : F.bid;
    const int cq = F.lane % 12, kr = F.lane / 12; const bool act = kr < 5;
    bool first = true;
    f32x4 cv[5];
#pragma unroll
    for (int j = 0; j < 5; ++j) cv[j] = *(const f32x4*)((j < 4 ? p.c + j * 2048 : p.c_ctx) + 4 * F.tid);
    for (int chunk = vcu; chunk < 256; chunk += F.G) {
        const float* wp = p.w_ada + (size_t)chunk * 48 + cq * 4;
        f32x4 wa[26];
        if (act) {
            { unsigned wo = (unsigned)((chunk * 48 + cq * 4 + (F.wave * 5 + kr) * 12288) * 4);
#pragma unroll
              for (int u = 0; u < 26; ++u) { wa[u] = __builtin_nontemporal_load((const f32x4*)((const char*)p.w_ada + wo)); wo += 40u * 12288u * 4u; asm volatile("" : "+v"(wo)); } } }
        if (first) { first = false;
#pragma unroll
            for (int j = 0; j < 5; ++j) { f32x4 o; o[0] = siluf(cv[j][0]); o[1] = siluf(cv[j][1]); o[2] = siluf(cv[j][2]); o[3] = siluf(cv[j][3]); *(LAS f32x4*)(sv + j * 2080 + 4 * F.tid) = o; }
            if (F.tid < 160) sv[(F.tid >> 5) * 2080 + 2048 + (F.tid & 31)] = 0.f;
            if (F.bid == 0 && F.tid < 64) ((unsigned*)p.ws)[CW_CNT + F.tid] = 0u;
            { u32x4* rz = (u32x4*)(p.ws + WS_ROWS); for (int i = F.bid * 512 + F.tid; i < 64 * 8192 / 4; i += F.G * 512) rz[i] = (u32x4){0u, 0u, 0u, 0u}; }
            __syncthreads(); }
        f32x4 acc[5];
#pragma unroll
        for (int r = 0; r < 5; ++r) acc[r] = (f32x4){0.f, 0.f, 0.f, 0.f};
        if (act) {
#pragma unroll
            for (int u = 0; u < 26; ++u) { const int k = u * 40 + F.wave * 5 + kr;
#pragma unroll
                for (int r = 0; r < 5; ++r) acc[r] += sv[r * 2080 + k] * wa[u]; }
            asm volatile("" ::: "memory");
#pragma unroll 1
            for (int it0 = 26; it0 < 52; it0 += 13) { f32x4 wv[13];
#pragma unroll
                for (int u = 0; u < 13; ++u) { int k = (it0 + u) * 40 + F.wave * 5 + kr; k = k < 2048 ? k : 2047; wv[u] = __builtin_nontemporal_load((const f32x4*)(wp + (size_t)k * 12288)); }
#pragma unroll
                for (int u = 0; u < 13; ++u) { const int k = (it0 + u) * 40 + F.wave * 5 + kr;
#pragma unroll
                    for (int r = 0; r < 5; ++r) acc[r] += sv[r * 2080 + k] * wv[u]; } }
#pragma unroll
            for (int r = 0; r < 5; ++r) *(LAS f32x4*)(red + ((F.wave * 5 + kr) * 5 + r) * 48 + cq * 4) = acc[r];
        }
        __syncthreads();
        if (F.tid < 240) { const int r = F.tid / 48, c = F.tid % 48; float s = p.b_ada[chunk * 48 + c];
            for (int g = 0; g < 40; ++g) s += red[(g * 5 + r) * 48 + c];
            mod[r * 12288 + chunk * 48 + c] = s; }
        __syncthreads();
    }
}
__device__ __forceinline__ float bflo(unsigned w) { return __builtin_bit_cast(float, w << 16); }
__device__ __forceinline__ float bfhi(unsigned w) { return __builtin_bit_cast(float, w & 0xffff0000u); }
__device__ __forceinline__ void conv_row(const P& p, int m, int lane) {
    const bf16* Z = (const bf16*)(p.ws + WS_Z); const bf16* BG = (const bf16*)(p.ws + WS_BG); const int i = m & 63;
    float cy[2][8]; float ss = 0.f;
#pragma unroll
    for (int j = 0; j < 2; ++j) { const int ch = 8 * lane + 512 * j;
        const u32x4 zc = *(const u32x4*)(Z + (size_t)m * DS + ch), zl = i > 0 ? *(const u32x4*)(Z + (size_t)(m - 1) * DS + ch) : (u32x4){0u, 0u, 0u, 0u}, zr = i < 63 ? *(const u32x4*)(Z + (size_t)(m + 1) * DS + ch) : (u32x4){0u, 0u, 0u, 0u};
        const u32x4 bg = *(const u32x4*)(BG + (size_t)m * DS + ch);
        const f32x4 cb0 = *(const f32x4*)(p.conv_b + ch), cb1 = *(const f32x4*)(p.conv_b + ch + 4), w00 = *(const f32x4*)(p.conv_w + ch), w01 = *(const f32x4*)(p.conv_w + ch + 4),
                    w10 = *(const f32x4*)(p.conv_w + DS + ch), w11 = *(const f32x4*)(p.conv_w + DS + ch + 4), w20 = *(const f32x4*)(p.conv_w + 2 * DS + ch), w21 = *(const f32x4*)(p.conv_w + 2 * DS + ch + 4);
#pragma unroll
        for (int e = 0; e < 8; ++e) { const float l_ = (e & 1) ? bfhi(zl[e >> 1]) : bflo(zl[e >> 1]), c_ = (e & 1) ? bfhi(zc[e >> 1]) : bflo(zc[e >> 1]), r_ = (e & 1) ? bfhi(zr[e >> 1]) : bflo(zr[e >> 1]);
            const float bgv = (e & 1) ? bfhi(bg[e >> 1]) : bflo(bg[e >> 1]);
            const float cb = e < 4 ? cb0[e & 3] : cb1[e & 3], w0 = e < 4 ? w00[e & 3] : w01[e & 3], w1 = e < 4 ? w10[e & 3] : w11[e & 3], w2 = e < 4 ? w20[e & 3] : w21[e & 3];
            const float y = cb + w0 * l_ + w1 * c_ + w2 * r_; cy[j][e] = bgv * y; ss += cy[j][e] * cy[j][e]; } }
    const float rs = rsqrtf(wave_sum(ss) * (1.f / DS) + EPS);
#pragma unroll
    for (int j = 0; j < 2; ++j) { const int ch = 8 * lane + 512 * j; const f32x4 g0 = *(const f32x4*)(p.mix_g + DS + ch), g1 = *(const f32x4*)(p.mix_g + DS + ch + 4); u32x4 o;
#pragma unroll
        for (int e = 0; e < 4; ++e) { const float ga = e < 2 ? g0[2 * e] : g1[2 * e - 4], gb = e < 2 ? g0[2 * e + 1] : g1[2 * e - 3]; o[e] = pk2(cy[j][2 * e] * rs * ga, cy[j][2 * e + 1] * rs * gb); }
        *(u32x4*)((bf16*)(p.ws + WS_HEADS) + (size_t)m * D + DS + ch) = o; }
}
constexpr int SS_R1 = 0, SS_M1S = 528, SS_HS = 272, SS_T2 = 39168, SS_R2 = 69632, SS_R3 = 144384;
typedef float f32x2 __attribute__((ext_vector_type(2)));
__device__ __forceinline__ f32x2 cmul(f32x2 a, f32x2 b) { return (f32x2){a.x * b.x - a.y * b.y, a.x * b.y + a.y * b.x}; }
__device__ __forceinline__ f32x2 lam_pow(float lre, float lim, float dt, int e) { const float m = __expf((float)e * dt * lre), ang = (float)e * dt * lim; const float kq = rintf(ang * 0.15915494309189535f); float rr = fmaf(-kq, 6.28318548202514648f, ang); rr = fmaf(-kq, -1.7484556000744883e-07f, rr); const float s = __sinf(rr), c = __cosf(rr); return (f32x2){m * c, m * s}; }
__device__ __forceinline__ void ssm_item(const P& p, const Fr& F, int item) {
    const int b = item & 3, g = item >> 2, tid = F.tid, lane = F.lane, w = F.wave, fr = lane & 15, q = lane >> 4;
    LAS unsigned char* lds = F.lds;
    const bf16* U = (const bf16*)(p.ws + WS_U);
    bf16x8v ufr[8];
    { const bf16* ub = U + (size_t)(b * SEQ + (16 * w + fr) * 16 + (q >> 1)) * DS + g * 16 + 8 * (q & 1);
#pragma unroll
      for (int ks = 0; ks < 8; ++ks) ufr[ks] = *(const bf16x8v*)(ub + (size_t)(2 * ks) * DS); }
    float pl0r[2], pl0i[2], plbr0[2], plbi0[2], plbr1[2], plbi1[2], pldt[2]; f32x2 pb0v[2], pb1v[2], pc0[2], pc1[2];
#pragma unroll
    for (int d = 0; d < 2; ++d) { const int gd = d * 64 + g, p0 = tid & 63, pb0 = tid >> 4, pb1 = pb0 + 32, n = tid & 15;
        pldt[d] = p.log_dt[gd]; pl0r[d] = p.lam_re[gd * 64 + p0]; pl0i[d] = p.lam_im[gd * 64 + p0];
        plbr0[d] = p.lam_re[gd * 64 + pb0]; plbi0[d] = p.lam_im[gd * 64 + pb0]; plbr1[d] = p.lam_re[gd * 64 + pb1]; plbi1[d] = p.lam_im[gd * 64 + pb1];
        pb0v[d] = (f32x2){p.b_re[(size_t)(gd * 64 + pb0) * 16 + n], p.b_im[(size_t)(gd * 64 + pb0) * 16 + n]}; pb1v[d] = (f32x2){p.b_re[(size_t)(gd * 64 + pb1) * 16 + n], p.b_im[(size_t)(gd * 64 + pb1) * 16 + n]};
        pc0[d] = (f32x2){p.c_re[(size_t)gd * 1024 + tid], p.c_im[(size_t)gd * 1024 + tid]}; pc1[d] = (f32x2){p.c_re[(size_t)gd * 1024 + 512 + tid], p.c_im[(size_t)gd * 1024 + 512 + tid]}; }
    f32x4 acc[16];
#pragma unroll 1
    for (int d = 0; d < 2; ++d) {
        const float l0r = d ? pl0r[1] : pl0r[0], l0i = d ? pl0i[1] : pl0i[0], lbr0 = d ? plbr0[1] : plbr0[0], lbi0 = d ? plbi0[1] : plbi0[0], lbr1 = d ? plbr1[1] : plbr1[0], lbi1 = d ? plbi1[1] : plbi1[0];
        const f32x2 b0 = d ? pb0v[1] : pb0v[0], b1 = d ? pb1v[1] : pb1v[0], cc0 = d ? pc0[1] : pc0[0], cc1 = d ? pc1[1] : pc1[0];
        int fr_ = fr, q_ = q; asm volatile("" : "+v"(fr_), "+v"(q_));
        const float dt = __expf(d ? pldt[1] : pldt[0]);
        bf16x8v cfr[8];
        { const bf16* cb = U + (size_t)(T + b * CTXL + fr_ * 16 + (q_ >> 1)) * DS + g * 16 + 8 * (q_ & 1);
#pragma unroll
          for (int ks = 0; ks < 8; ++ks) cfr[ks] = *(const bf16x8v*)(cb + (size_t)(2 * ks) * DS); }
        LAS f32x2* Ltab = (LAS f32x2*)(lds + SS_R2); LAS f32x2* Btab = (LAS f32x2*)(lds + SS_R2 + 8704);
        { const int p0 = tid & 63, pb0 = tid >> 4, pb1 = pb0 + 32, n = tid & 15;
          for (int idx = tid; idx < 17 * 64; idx += 512) Ltab[idx] = lam_pow(l0r, l0i, dt, idx >> 6);
          { const f32x2 lb = lam_pow(lbr0, lbi0, dt, 1); const float nr = lb.x - 1.f, ni = lb.y, den = lbr0 * lbr0 + lbi0 * lbi0; Btab[tid] = cmul((f32x2){(nr * lbr0 + ni * lbi0) / den, (ni * lbr0 - nr * lbi0) / den}, b0); }
          { const f32x2 lb = lam_pow(lbr1, lbi1, dt, 1); const float nr = lb.x - 1.f, ni = lb.y, den = lbr1 * lbr1 + lbi1 * lbi1; Btab[tid + 512] = cmul((f32x2){(nr * lbr1 + ni * lbi1) / den, (ni * lbr1 - nr * lbi1) / den}, b1); } }
        __syncthreads();
        const f32x2 A16 = Ltab[16 * 64 + lane];
        for (int idx = tid; idx < 1024; idx += 512) { const int pp = idx & 63, j = idx >> 6, e = d == 0 ? 15 - j : j; const f32x2 wv = Ltab[e * 64 + pp];
            u32x4 re0, re1, im0, im1;
#pragma unroll
            for (int n2 = 0; n2 < 8; ++n2) { const f32x2 v0 = cmul(wv, Btab[pp * 16 + 2 * n2]), v1 = cmul(wv, Btab[pp * 16 + 2 * n2 + 1]);
                const unsigned r = pk2(v0.x, v1.x), im = pk2(v0.y, v1.y); if (n2 < 4) { re0[n2] = r; im0[n2] = im; } else { re1[n2 - 4] = r; im1[n2 - 4] = im; } }
            LAS unsigned char* r0 = lds + SS_R1 + pp * SS_M1S + j * 32; LAS unsigned char* r1 = lds + SS_R1 + (64 + pp) * SS_M1S + j * 32;
            *(LAS u32x4*)r0 = re0; *(LAS u32x4*)(r0 + 16) = re1; *(LAS u32x4*)r1 = im0; *(LAS u32x4*)(r1 + 16) = im1; }
        __syncthreads();
        { LAS float* S = (LAS float*)(lds + SS_R2);
#pragma unroll 2
          for (int rt = 0; rt < 8; ++rt) { f32x4 sa = (f32x4){0.f, 0.f, 0.f, 0.f};
#pragma unroll
              for (int ks = 0; ks < 8; ++ks) { const bf16x8v af = *(const LAS bf16x8v*)(lds + SS_R1 + (rt * 16 + fr_) * SS_M1S + (ks * 32 + 8 * q_) * 2); sa = __builtin_amdgcn_mfma_f32_16x16x32_bf16(af, ufr[ks], sa, 0, 0, 0); }
              *(LAS f32x4*)(S + (16 * w + fr_) * 128 + rt * 16 + 4 * q_) = sa; }
          { f32x4 sc_ = (f32x4){0.f, 0.f, 0.f, 0.f};
#pragma unroll
            for (int ks = 0; ks < 8; ++ks) { const bf16x8v cf = cfr[ks]; const bf16x8v af = *(const LAS bf16x8v*)(lds + SS_R1 + (w * 16 + fr_) * SS_M1S + (ks * 32 + 8 * q_) * 2);
                sc_ = __builtin_amdgcn_mfma_f32_16x16x32_bf16(af, cf, sc_, 0, 0, 0); }
            *(LAS f32x4*)(S + (128 + fr_) * 128 + w * 16 + 4 * q_) = sc_; } }
        __syncthreads();
        { const LAS float* S = (const LAS float*)(lds + SS_R2); LAS float* Tg = (LAS float*)(lds + SS_R1 + SS_T2 + 16896);
          float hr = 0.f, hi = 0.f;
#pragma unroll 4
          for (int s = 0; s < 16; ++s) { const int c = 128 + (d == 0 ? s : 15 - s); const float sr_ = S[c * 128 + lane], si_ = S[c * 128 + 64 + lane];
              const float nr = A16.x * hr - A16.y * hi + sr_, ni = A16.x * hi + A16.y * hr + si_; hr = nr; hi = ni; }
          float tr = 0.f, ti = 0.f;
#pragma unroll 4
          for (int s = 0; s < 16; ++s) { const int c = 16 * w + (d == 0 ? s : 15 - s); const float sr_ = S[c * 128 + lane], si_ = S[c * 128 + 64 + lane];
              const float nr = A16.x * tr - A16.y * ti + sr_, ni = A16.x * ti + A16.y * tr + si_; tr = nr; ti = ni; }
          Tg[w * 128 + lane] = tr; Tg[w * 128 + 64 + lane] = ti;
          f32x2 A256 = A16;
#pragma unroll
          for (int s = 0; s < 4; ++s) A256 = cmul(A256, A256);
          { LAS f32x2* L2 = (LAS f32x2*)(lds + SS_R1 + SS_T2); LAS f32x2* C2 = (LAS f32x2*)(lds + SS_R1 + SS_T2 + 8704); LAS unsigned char* B2T = lds + SS_R1 + SS_T2 + 16896 + 4096;
            const int p0 = tid & 63, pb0 = tid >> 4, pb1 = pb0 + 32, n = tid & 15;
            C2[tid] = cc0; C2[tid + 512] = cc1;
            for (int idx = tid; idx < 17 * 64; idx += 512) L2[idx] = lam_pow(l0r, l0i, dt, idx >> 6);
            { const f32x2 lb = lam_pow(lbr0, lbi0, dt, 1); const float nr = lb.x - 1.f, ni = lb.y, den = lbr0 * lbr0 + lbi0 * lbi0; const f32x2 v = cmul((f32x2){(nr * lbr0 + ni * lbi0) / den, (ni * lbr0 - nr * lbi0) / den}, b0);
              *(LAS bf16*)(B2T + n * SS_HS + pb0 * 2) = (bf16)f2bf(v.x); *(LAS bf16*)(B2T + n * SS_HS + (64 + pb0) * 2) = (bf16)f2bf(v.y); }
            { const f32x2 lb = lam_pow(lbr1, lbi1, dt, 1); const float nr = lb.x - 1.f, ni = lb.y, den = lbr1 * lbr1 + lbi1 * lbi1; const f32x2 v = cmul((f32x2){(nr * lbr1 + ni * lbi1) / den, (ni * lbr1 - nr * lbi1) / den}, b1);
              *(LAS bf16*)(B2T + n * SS_HS + pb1 * 2) = (bf16)f2bf(v.x); *(LAS bf16*)(B2T + n * SS_HS + (64 + pb1) * 2) = (bf16)f2bf(v.y); } }
          __syncthreads();
          const int nprev = d == 0 ? w : 7 - w;
          for (int s = 0; s < nprev; ++s) { const int sg = d == 0 ? s : 7 - s; const float t0_ = Tg[sg * 128 + lane], t1_ = Tg[sg * 128 + 64 + lane];
              const float nr = A256.x * hr - A256.y * hi + t0_, ni = A256.x * hi + A256.y * hr + t1_; hr = nr; hi = ni; }
#pragma unroll 4
          for (int s = 0; s < 16; ++s) { const int c = 16 * w + (d == 0 ? s : 15 - s); const float sr_ = S[c * 128 + lane], si_ = S[c * 128 + 64 + lane];
              *(LAS bf16*)(lds + SS_R1 + c * SS_HS + lane * 2) = (bf16)f2bf(hr); *(LAS bf16*)(lds + SS_R1 + c * SS_HS + (64 + lane) * 2) = (bf16)f2bf(hi);
              const float nr = A16.x * hr - A16.y * hi + sr_, ni = A16.x * hi + A16.y * hr + si_; hr = nr; hi = ni; } }
        __syncthreads();
        { const LAS f32x2* L2 = (const LAS f32x2*)(lds + SS_R1 + SS_T2); const LAS f32x2* C2 = (const LAS f32x2*)(lds + SS_R1 + SS_T2 + 8704);
          for (int idx = tid; idx < 17 * 64; idx += 512) { const int pp = idx & 63, tau = idx >> 6; const f32x2 wv = L2[tau * 64 + pp];
#pragma unroll
              for (int n = 0; n < 16; ++n) { const f32x2 v = cmul(C2[n * 64 + pp], wv); LAS unsigned char* rp = lds + SS_R2 + (tau * 16 + n) * SS_HS;
                  *(LAS bf16*)(rp + pp * 2) = (bf16)f2bf(v.x); *(LAS bf16*)(rp + (64 + pp) * 2) = (bf16)f2bf(-v.y); } } }
        __syncthreads();
        { const LAS unsigned char* B2T = lds + SS_R1 + SS_T2 + 16896 + 4096; bf16x8v bfg[4];
#pragma unroll
          for (int ks = 0; ks < 4; ++ks) bfg[ks] = *(const LAS bf16x8v*)(B2T + fr_ * SS_HS + (ks * 32 + 8 * q_) * 2);
#pragma unroll
          for (int t2 = 0; t2 < 2; ++t2) { const int tau = 2 * w + t2; f32x4 ka = (f32x4){0.f, 0.f, 0.f, 0.f};
#pragma unroll
              for (int ks = 0; ks < 4; ++ks) { const bf16x8v af = *(const LAS bf16x8v*)(lds + SS_R2 + (tau * 16 + fr_) * SS_HS + (ks * 32 + 8 * q_) * 2); ka = __builtin_amdgcn_mfma_f32_16x16x32_bf16(af, bfg[ks], ka, 0, 0, 0); }
#pragma unroll
              for (int r = 0; r < 4; ++r) *(LAS bf16*)(lds + SS_R3 + ((tau * 16 + 4 * q_ + r) * 16 + fr_) * 2) = (bf16)f2bf(ka[r]); }
          if (tid < 32) *(LAS u32x4*)(lds + SS_R3 + 16 * 512 + tid * 16) = (u32x4){0u, 0u, 0u, 0u}; }
        __syncthreads();
        { bf16x8v hfr[4];
#pragma unroll
          for (int ks = 0; ks < 4; ++ks) hfr[ks] = *(const LAS bf16x8v*)(lds + SS_R1 + (16 * w + fr_) * SS_HS + (ks * 32 + 8 * q_) * 2);
#define SSM_F(DD) do { _Pragma("unroll") for (int i = 0; i < 16; ++i) { \
              _Pragma("unroll") for (int ks = 0; ks < 4; ++ks) { const bf16x8v af = *(const LAS bf16x8v*)(lds + SS_R2 + (((DD) == 0 ? i + 1 : 16 - i) * 16 + fr_) * SS_HS + (ks * 32 + 8 * q_) * 2); acc[i] = __builtin_amdgcn_mfma_f32_16x16x32_bf16(af, hfr[ks], ((DD) == 0 && ks == 0) ? (f32x4){0.f, 0.f, 0.f, 0.f} : acc[i], 0, 0, 0); } \
              _Pragma("unroll") for (int ks = 0; ks < 8; ++ks) { if ((DD) == 0 ? (2 * ks <= i) : (2 * ks + 1 >= i)) { const int j = 2 * ks + (q_ >> 1); const bool ok = (DD) == 0 ? (j <= i) : (j >= i); const int tau = ok ? (j > i ? j - i : i - j) : 16; \
                      const bf16x8v af = *(const LAS bf16x8v*)(lds + SS_R3 + ((tau * 16 + fr_) * 16 + 8 * (q_ & 1)) * 2); acc[i] = __builtin_amdgcn_mfma_f32_16x16x32_bf16(af, ufr[ks], acc[i], 0, 0, 0); } } \
              if (i & 1) __builtin_amdgcn_sched_barrier(0); } } while (0)
          if (d == 0) SSM_F(0); else SSM_F(1);
#undef SSM_F
        }
        __syncthreads();
    }
    { const int ch0 = g * 16 + 4 * q; const f32x4 dsk = *(const f32x4*)(p.ssm_d + ch0); bf16* GY = (bf16*)(p.ws + WS_GY);
#pragma unroll
      for (int i = 0; i < 16; ++i) { const size_t off = (size_t)(b * SEQ + (16 * w + fr) * 16 + i) * DS + ch0; const u32x2 uu = *(const u32x2*)(U + off);
          const float y0 = acc[i][0] + dsk[0] * bflo(uu.x), y1 = acc[i][1] + dsk[1] * bfhi(uu.x), y2 = acc[i][2] + dsk[2] * bflo(uu.y), y3 = acc[i][3] + dsk[3] * bfhi(uu.y);
          u32x2 o; o.x = pk2(gelu_fast(y0), gelu_fast(y1)); o.y = pk2(gelu_fast(y2), gelu_fast(y3)); *(u32x2*)(GY + off) = o; } }
}
__device__ __forceinline__ void ph_ssm(const P& p, const Fr& F) {
    for (int item = F.bid; item < 256; item += F.G) ssm_item(p, F, item);
    const int gw = F.bid * NWAVES + F.wave, NGW = F.G * NWAVES;
    for (int m = gw; m < T; m += NGW) conv_row(p, m, F.lane);
}
typedef float f32x16 __attribute__((ext_vector_type(16)));
constexpr int RT_STG = 16640;
__device__ __forceinline__ void ph_route(const P& p, const Fr& F) {
    LAS float* Gv = (LAS float*)F.lds; LAS float* Sh = Gv + 2048; LAS float* RS = Gv + 4096;
    LAS float* LG = (LAS float*)F.lds;
    LAS float* GS = (LAS float*)(F.lds + 8192);
    LAS unsigned* rec = (LAS unsigned*)(F.lds + 9216);
    LAS float* rwt = (LAS float*)(F.lds + 10240);
    LAS unsigned* lcnt = (LAS unsigned*)(F.lds + RT_STG + 131072);
    const float* x1 = p.out; unsigned char* XN8 = p.ws + WS_XN8; const float* rsx = (const float*)(p.ws + WS_RSP_X1);
    const bf16* WH = (const bf16*)(p.ws + WS_WRT_HI); const bf16* WL = (const bf16*)(p.ws + WS_WRT_LO);
    for (int grp = F.bid; grp < T / 32; grp += F.G) {
        const int t0 = grp * 32, b = t0 / SEQ; const float* mod = (const float*)(p.ws + WS_MOD) + b * 12288;
        const int r = F.lane & 31, h = F.lane >> 5;
        LAS unsigned char* stg = F.lds + RT_STG + F.wave * 16384;
        unsigned wo = (unsigned)((F.wave * 2048 + F.lane) * 16);
        unsigned xo = (unsigned)(((t0 + (F.lane >> 4)) * D + F.wave * 256 + 4 * (F.lane & 15)) * 4);
        asm volatile("" : "+v"(wo), "+v"(xo));
        bf16x8v bh[2][2][2], bl[2][2][2];
#define RT_LDB(buf) do { _Pragma("unroll") for (int j = 0; j < 2; ++j) _Pragma("unroll") for (int s_ = 0; s_ < 2; ++s_) { bh[buf][j][s_] = *(const bf16x8v*)((const char*)WH + wo + (j * 2 + s_) * 1024); bl[buf][j][s_] = *(const bf16x8v*)((const char*)WL + wo + (j * 2 + s_) * 1024); } \
            wo += 4096u; asm volatile("" : "+v"(wo)); } while (0)
#define RT_DMA(q) do { _Pragma("unroll") for (int c = 0; c < 8; ++c) __builtin_amdgcn_global_load_lds((const unsigned*)((const char*)x1 + xo + (unsigned)((4 * c * D + 64 * (q)) * 4)), (LAS unsigned*)(stg + ((q) & 1) * 8192 + c * 1024), 16, 0, 2); } while (0)
        RT_LDB(0); RT_DMA(0); RT_DMA(1);
        { const int k = 4 * F.tid; const f32x4 g = *(const f32x4*)(p.norm2_g + k), sc = *(const f32x4*)(mod + 4 * 2048 + k), sh = *(const f32x4*)(mod + 3 * 2048 + k);
          *(LAS f32x4*)(Gv + k) = g * (1.f + sc); *(LAS f32x4*)(Sh + k) = sh; }
        if (F.tid < 64) lcnt[F.tid] = 0u;
        { float a0 = rsx[(t0 + 4 * F.wave + h) * 32 + r], a1 = rsx[(t0 + 4 * F.wave + 2 + h) * 32 + r];
#pragma unroll
          for (int o = 1; o < 32; o <<= 1) { a0 += __shfl_xor(a0, o); a1 += __shfl_xor(a1, o); }
          if (r == 0) { RS[4 * F.wave + h] = rsqrtf(a0 * (1.f / D) + EPS); RS[4 * F.wave + 2 + h] = rsqrtf(a1 * (1.f / D) + EPS); } }
        __syncthreads();
        { const float rs = RS[r]; const int kk0 = F.wave * 256 + 16 * h;
          unsigned oo = (unsigned)((t0 + r) * D + kk0); asm volatile("" : "+v"(oo));
          const LAS unsigned char* xl = stg + (r >> 2) * 1024 + (r & 3) * 256 + h * 64;
          f32x16 c1[2], c2[2];
#pragma unroll
          for (int j = 0; j < 2; ++j)
#pragma unroll
              for (int v = 0; v < 16; ++v) { c1[j][v] = 0.f; c2[j][v] = 0.f; }
          asm volatile("s_waitcnt vmcnt(8)" ::: "memory");
#pragma unroll
          for (int t = 0; t < 8; ++t) {
              if (t + 1 < 8) RT_LDB((t + 1) & 1);
              f32x4 y[4];
#pragma unroll
              for (int i = 0; i < 4; ++i) { const f32x4 xv = *(const LAS f32x4*)(xl + ((t >> 1) & 1) * 8192 + (t & 1) * 128 + 16 * i);
                  const f32x4 gq = *(const LAS f32x4*)(Gv + kk0 + 32 * t + 4 * i), sq = *(const LAS f32x4*)(Sh + kk0 + 32 * t + 4 * i); y[i] = (xv * rs) * gq + sq; }
              u32x4 o8;
#pragma unroll
              for (int i = 0; i < 4; ++i) o8[i] = pk4_fp8(16.f * y[i][0], 16.f * y[i][1], 16.f * y[i][2], 16.f * y[i][3]);
              *(u32x4*)(XN8 + oo + 32 * t) = o8;
              bf16x8v ah[2], al[2];
#pragma unroll
              for (int s_ = 0; s_ < 2; ++s_) { u32x4 wh_, wl_;
#pragma unroll
                  for (int i2 = 0; i2 < 4; ++i2) { const float v0 = y[2 * s_ + (i2 >> 1)][2 * (i2 & 1)], v1 = y[2 * s_ + (i2 >> 1)][2 * (i2 & 1) + 1]; const unsigned hw = pg8::cvt_pk_bf16(v0, v1);
                      wh_[i2] = hw; wl_[i2] = pg8::cvt_pk_bf16(v0 - __builtin_bit_cast(float, hw << 16), v1 - __builtin_bit_cast(float, hw & 0xffff0000u)); }
                  ah[s_] = __builtin_bit_cast(bf16x8v, wh_); al[s_] = __builtin_bit_cast(bf16x8v, wl_); }
#pragma unroll
              for (int s_ = 0; s_ < 2; ++s_) {
                  c1[0] = __builtin_amdgcn_mfma_f32_32x32x16_bf16(ah[s_], bh[t & 1][0][s_], c1[0], 0, 0, 0); c1[1] = __builtin_amdgcn_mfma_f32_32x32x16_bf16(ah[s_], bh[t & 1][1][s_], c1[1], 0, 0, 0);
                  c2[0] = __builtin_amdgcn_mfma_f32_32x32x16_bf16(ah[s_], bl[t & 1][0][s_], c2[0], 0, 0, 0); c2[1] = __builtin_amdgcn_mfma_f32_32x32x16_bf16(ah[s_], bl[t & 1][1][s_], c2[1], 0, 0, 0);
                  c1[0] = __builtin_amdgcn_mfma_f32_32x32x16_bf16(al[s_], bh[t & 1][0][s_], c1[0], 0, 0, 0); c1[1] = __builtin_amdgcn_mfma_f32_32x32x16_bf16(al[s_], bh[t & 1][1][s_], c1[1], 0, 0, 0); }
              if (t & 1) {
                  asm volatile("s_waitcnt lgkmcnt(0)" ::: "memory");
                  if ((t >> 1) + 2 < 4) { RT_DMA((t >> 1) + 2); asm volatile("s_waitcnt vmcnt(8)" ::: "memory"); } else asm volatile("s_waitcnt vmcnt(0)" ::: "memory"); }
              else asm volatile("" ::: "memory");
          }
          LAS float* PLw = (LAS float*)stg;
#pragma unroll
          for (int j = 0; j < 2; ++j)
#pragma unroll
              for (int v = 0; v < 16; ++v) PLw[(8 * (v >> 2) + 4 * h + (v & 3)) * 64 + 32 * j + r] = c1[j][v] + c2[j][v]; }
#undef RT_DMA
#undef RT_LDB
        __syncthreads();
        const float rbias = p.router_b[F.lane];
#pragma unroll 1
        for (int tt = 0; tt < 4; ++tt) { const int ti = F.wave * 4 + tt, e = F.lane; LAS float* row = LG + ti * 64; LAS float* gsa = GS + ti * 8;
            float lg = ((const LAS float*)(F.lds + RT_STG))[ti * 64 + e];
#pragma unroll
            for (int k8 = 1; k8 < 8; ++k8) lg += ((const LAS float*)(F.lds + RT_STG + k8 * 16384))[ti * 64 + e];
            const float sc = sigmf(lg); const float bz = sc + rbias;
            row[e] = bz; asm volatile("s_waitcnt lgkmcnt(0)" ::: "memory");
            { const f32x4 g0 = *(const LAS f32x4*)(row + (e & ~7)), g1 = *(const LAS f32x4*)(row + (e & ~7) + 4); float m1 = -INFINITY, m2 = -INFINITY;
#pragma unroll
              for (int j = 0; j < 8; ++j) { const float x = j < 4 ? g0[j] : g1[j - 4]; const float lo = fminf(m1, x); m1 = fmaxf(m1, x); m2 = fmaxf(m2, lo); }
              if ((e & 7) == 0) gsa[e >> 3] = m1 + m2; }
            asm volatile("s_waitcnt lgkmcnt(0)" ::: "memory");
            int grk = 0; const int g = e >> 3; float gs;
            { const f32x4 s0 = *(const LAS f32x4*)gsa, s1 = *(const LAS f32x4*)(gsa + 4); gs = g < 4 ? s0[g & 3] : s1[g & 3];
#pragma unroll
              for (int j = 0; j < 8; ++j) { const float o = j < 4 ? s0[j] : s1[j - 4]; grk += (o > gs || (o == gs && j < g)) ? 1 : 0; } }
            const bool gsel = grk < 4; const float bm = gsel ? bz : -INFINITY;
            asm volatile("s_waitcnt lgkmcnt(0)" ::: "memory"); row[e] = bm; asm volatile("s_waitcnt lgkmcnt(0)" ::: "memory");
            int erk = 0;
#pragma unroll 4
            for (int j4 = 0; j4 < 16; ++j4) { const f32x4 o = *(const LAS f32x4*)(row + 4 * j4);
#pragma unroll
                for (int t = 0; t < 4; ++t) erk += (o[t] > bm || (o[t] == bm && 4 * j4 + t < e)) ? 1 : 0; }
            const bool sel = gsel && erk < 8;
            const float wsum = wave_sum(sel ? sc : 0.f);
            if (sel) { const unsigned loc = __hip_atomic_fetch_add(&lcnt[e], 1u, __ATOMIC_RELAXED, __HIP_MEMORY_SCOPE_WORKGROUP); rec[ti * 8 + erk] = ((unsigned)e << 16) | loc; rwt[ti * 8 + erk] = sc / wsum * 2.5f; } }
        __syncthreads();
        if (F.tid < 64) { const unsigned n = lcnt[F.tid]; lcnt[64 + F.tid] = n ? atomicAdd((unsigned*)p.ws + CW_CNT + F.tid, n) : 0u; }
        __syncthreads();
        if (F.tid < 256) { const unsigned rv = rec[F.tid], e = rv >> 16, idx = lcnt[64 + e] + (rv & 0xffffu); const int row = t0 + (F.tid >> 3);
            ((int*)(p.ws + WS_ROWS))[e * 8192 + idx] = row; ((unsigned*)(p.ws + WS_POS))[row * 8 + (F.tid & 7)] = (e << 16) | idx; ((float*)(p.ws + WS_WTS))[row * 8 + (F.tid & 7)] = rwt[F.tid]; }
        __syncthreads();
    }
}
typedef float f32x2_ __attribute__((ext_vector_type(2)));
struct FinBuf { u32x4 y[9]; f32x4 xa0, xa1, xb0, xb1, ga0, ga1, gb0, gb1; };
__device__ __forceinline__ void fin_acc(float (&a)[16], const u32x4 y, const float w) {
#pragma unroll
    for (int d = 0; d < 4; ++d) { const f32x2_ lo = __builtin_amdgcn_cvt_pk_f32_fp8((int)y[d], false), hi = __builtin_amdgcn_cvt_pk_f32_fp8((int)y[d], true);
        a[4 * d] += w * lo.x; a[4 * d + 1] += w * lo.y; a[4 * d + 2] += w * hi.x; a[4 * d + 3] += w * hi.y; }
}
__device__ __forceinline__ void ph_final(const P& p, const Fr& F) {
    float* dst = p.out;
    const int gw = F.bid * NWAVES + F.wave, NGW = F.G * NWAVES; const unsigned char* YS = p.ws + WS_YS;
    LAS float* xs = (LAS float*)(F.lds + F.wave * 8192);
    unsigned pv = 0u; float wv = 0.f; if (gw < T && F.lane < 8) { pv = ((const unsigned*)(p.ws + WS_POS))[gw * 8 + F.lane]; wv = ((const float*)(p.ws + WS_WTS))[gw * 8 + F.lane]; }
    for (int row = gw; row < T; row += NGW) {
        const int b = row / SEQ; const float* g2 = (const float*)(p.ws + WS_MOD) + b * 12288 + 5 * 2048; const float* xr = p.out + (size_t)row * D;
        unsigned rows[8]; float w[8];
#pragma unroll
        for (int r = 0; r < 8; ++r) { const unsigned pr = (unsigned)__shfl((int)pv, r); w[r] = __shfl(wv, r) * 0.0625f; rows[r] = F.misc[MW_SEG + (pr >> 16)] + (pr & 0xffffu); }
        { const int nrow = row + NGW; pv = 0u; wv = 0.f; if (nrow < T && F.lane < 8) { pv = ((const unsigned*)(p.ws + WS_POS))[nrow * 8 + F.lane]; wv = ((const float*)(p.ws + WS_WTS))[nrow * 8 + F.lane]; } }
        float ss = 0.f;
#pragma unroll 1
        for (int j = 0; j < 2; ++j) { const int q16 = F.lane + 64 * j, f0 = 256 * (q16 >> 4) + 32 * ((q16 >> 2) & 3) + 8 * (q16 & 3), f1 = f0 + 128; FinBuf B;
            B.y[0] = __builtin_nontemporal_load((const u32x4*)(YS + (size_t)row * D + q16 * 16));
#pragma unroll
            for (int r = 0; r < 8; ++r) B.y[1 + r] = __builtin_nontemporal_load((const u32x4*)(YS + (size_t)rows[r] * D + q16 * 16));
            B.xa0 = __builtin_nontemporal_load((const f32x4*)(xr + f0)); B.xa1 = __builtin_nontemporal_load((const f32x4*)(xr + f0 + 4)); B.xb0 = __builtin_nontemporal_load((const f32x4*)(xr + f1)); B.xb1 = __builtin_nontemporal_load((const f32x4*)(xr + f1 + 4));
            B.ga0 = *(const f32x4*)(g2 + f0); B.ga1 = *(const f32x4*)(g2 + f0 + 4); B.gb0 = *(const f32x4*)(g2 + f1); B.gb1 = *(const f32x4*)(g2 + f1 + 4);
            float a[16];
#pragma unroll
            for (int e = 0; e < 16; ++e) a[e] = 0.f;
            fin_acc(a, B.y[0], 0.0625f);
#pragma unroll
            for (int r = 0; r < 8; ++r) fin_acc(a, B.y[1 + r], w[r]);
            f32x4 v0, v1, v2, v3;
#pragma unroll
            for (int e = 0; e < 4; ++e) { v0[e] = B.xa0[e] + B.ga0[e] * a[e]; v1[e] = B.xa1[e] + B.ga1[e] * a[4 + e]; v2[e] = B.xb0[e] + B.gb0[e] * a[8 + e]; v3[e] = B.xb1[e] + B.gb1[e] * a[12 + e];
                ss += (v0[e] * v0[e] + v1[e] * v1[e]) + (v2[e] * v2[e] + v3[e] * v3[e]); }
            *(LAS f32x4*)(xs + f0) = v0; *(LAS f32x4*)(xs + f0 + 4) = v1; *(LAS f32x4*)(xs + f1) = v2; *(LAS f32x4*)(xs + f1 + 4) = v3; }
        const float rs = rsqrtf(wave_sum(ss) * (1.f / D) + EPS);
        float* orow = dst + (size_t)row * D;
#pragma unroll 1
        for (int j = 0; j < 4; ++j) { const int k = 8 * F.lane + 512 * j; const f32x4 f0 = *(const f32x4*)(p.final_g + k), f1 = *(const f32x4*)(p.final_g + k + 4);
            const f32x4 v0 = *(const LAS f32x4*)(xs + k), v1 = *(const LAS f32x4*)(xs + k + 4);
            __builtin_nontemporal_store(v0 * rs * f0, (f32x4*)(orow + k)); __builtin_nontemporal_store(v1 * rs * f1, (f32x4*)(orow + k + 4)); }
    }
}

__device__ __forceinline__ void ctx_piece(const P& p, const Fr& F, int piece) {
    const int mi = piece >> 4, ni = piece & 15, fr = F.lane & 15, q = F.lane >> 4, w = F.wave;
    const bf16* A = (const bf16*)(p.ws + WS_XN) + (size_t)(T + 64 * mi + fr) * D + w * 256 + 8 * q;
    const bf16* B = (const bf16*)(p.ws + WS_WIN_T) + (size_t)(64 * ni + fr) * D + w * 256 + 8 * q;
    f32x4 acc[4][4];
#pragma unroll
    for (int a = 0; a < 4; ++a)
#pragma unroll
        for (int b = 0; b < 4; ++b) acc[a][b] = (f32x4){0.f, 0.f, 0.f, 0.f};
#pragma unroll 2
    for (int s = 0; s < 8; ++s) { bf16x8v af[4], bfr[4];
#pragma unroll
        for (int t = 0; t < 4; ++t) { af[t] = *(const bf16x8v*)(A + (size_t)(16 * t) * D + s * 32); bfr[t] = *(const bf16x8v*)(B + (size_t)(16 * t) * D + s * 32); }
#pragma unroll
        for (int a = 0; a < 4; ++a)
#pragma unroll
            for (int b = 0; b < 4; ++b) acc[a][b] = __builtin_amdgcn_mfma_f32_16x16x32_bf16(af[a], bfr[b], acc[a][b], 0, 0, 0); }
    LAS f32x4* part = (LAS f32x4*)F.lds;
#pragma unroll
    for (int a = 0; a < 4; ++a)
#pragma unroll
        for (int b = 0; b < 4; ++b) part[(w * 16 + a * 4 + b) * 64 + F.lane] = acc[a][b];
    __syncthreads();
    for (int o = F.tid; o < 1024; o += 512) { const int tile = o >> 6, ln = o & 63; f32x4 s = part[tile * 64 + ln];
#pragma unroll
        for (int ww = 1; ww < 8; ++ww) s += part[(ww * 16 + tile) * 64 + ln];
        const int a = tile >> 2, b = tile & 3, c = ln & 15, qq = ln >> 4; bf16* U = (bf16*)(p.ws + WS_U) + (size_t)(T + 64 * mi + 16 * a + 4 * qq) * DS + 64 * ni + 16 * b + c;
#pragma unroll
        for (int r = 0; r < 4; ++r) U[(size_t)r * DS] = (bf16)f2bf(s[r]); }
    __syncthreads();
}
__device__ __forceinline__ void moe1_conv_share(const Fr& F, int& first, int& count) {
    constexpr int U_ITEMS = 44;
    LAS int* NU = (LAS int*)F.lds;
    const int ntot = (int)F.misc[MW_UPRE + 65] * 4, chunk = (ntot + 7) >> 3;
    { const int base = CVS_DOWN / F.G, rem = CVS_DOWN % F.G; first = F.bid * base + (F.bid < rem ? F.bid : rem); count = base + (F.bid < rem ? 1 : 0); }
    if (F.G != 256) return;
    if (F.tid < 256) { const int x = F.tid & 7, j = F.tid >> 3; int len = ntot - x * chunk; len = len < chunk ? len : chunk; NU[F.tid] = j < len ? (len - 1 - j) / 32 + 1 : 0; }
    __syncthreads();
    int mx = 0;
    for (int b = 0; b < 256; b += 4) { const pg8::v4i_t v = *(const LAS pg8::v4i_t*)(NU + b); mx = max(max(mx, v[0]), max(max(v[1], v[2]), v[3])); }
    int below = 0, tot = 0;
    for (int b = 0; b < 256; b += 4) { const pg8::v4i_t v = *(const LAS pg8::v4i_t*)(NU + b);
#pragma unroll
        for (int i = 0; i < 4; ++i) { const int d = (mx - v[i]) * U_ITEMS; tot += d; below += (b + i < F.bid) ? d : 0; } }
    const int mine = (mx - NU[F.bid]) * U_ITEMS;
    __syncthreads();
    if (tot <= CVS_DOWN) { const int base = (CVS_DOWN - tot) / 256, rem = (CVS_DOWN - tot) % 256; first = F.bid * base + (F.bid < rem ? F.bid : rem) + below; count = base + (F.bid < rem ? 1 : 0) + mine; }
    first = __builtin_amdgcn_readfirstlane(first); count = __builtin_amdgcn_readfirstlane(count);
}
enum { PH_MOD = 0, PH_PRE, PH_INPROJ, PH_SSM, PH_GLU, PH_OUT, PH_ROUTE, PH_MOE1, PH_MOE2, PH_FINAL, PH_N };
struct Args { P p; int lo, hi, pad0, pad1; };
__global__ void __launch_bounds__(NWAVES * 64, 2) mk_fast(Args a) {
    extern __shared__ __attribute__((aligned(16))) unsigned char lds_raw[];
    const P& p = a.p;
    Fr F; F.lds = (LAS unsigned char*)lds_raw; F.misc = (volatile LAS unsigned*)(F.lds + MISC_OFF);
    F.tid = threadIdx.x; F.lane = F.tid & 63; F.wave = __builtin_amdgcn_readfirstlane(F.tid >> 6); F.G = gridDim.x; F.bid = blockIdx.x;
    if (F.tid < 16) F.misc[F.tid] = 0u;
    __syncthreads();
    XcdBarrier bar = xcd_barrier_post((unsigned*)p.ws + CW_BAR, F.misc + MW_BAR);
    unsigned char* ws = p.ws;
    const bool cv_early = (F.bid >> 3) < (F.G >> 4);
#define CVSL(set, a, b) conv_slice(p, F, set, (int)((long long)(set == 0 ? CVS_UP : CVS_DOWN) * (a) / 100) + F.bid * NWAVES, (int)((long long)(set == 0 ? CVS_UP : CVS_DOWN) * (b) / 100), F.G * NWAVES)
    const int lo = a.lo, hi = a.hi;
#define IN(k) (lo <= (k) && (k) < hi)
#define SEAM(k) do { if (IN(k) && IN((k) + 1)) xcd_barrier(bar); } while (0)
    if (IN(PH_MOD)) { ph_mod(p, F); } SEAM(PH_MOD);
    if (IN(PH_PRE)) { ph_pre(p, F); } SEAM(PH_PRE);
    if (IN(PH_INPROJ)) { if (cv_early) CVSL(0, 0, 45); }
    if (IN(PH_INPROJ)) {
        SDense S{(const char*)(ws + WS_XN), (const char*)(ws + WS_WIN_T), 32, 16, 0, 1, 2048, F.G, F.bid};
        EpiInProj E{(bf16*)(ws + WS_U), (bf16*)(ws + WS_BG), (bf16*)(ws + WS_Z)};
        pg8::gemm_phase<EpiInProj, SDense, true, false>(F.lds, nullptr, 2048, S, E);
        for (int piece = F.bid; piece < 256; piece += F.G) ctx_piece(p, F, piece);
    }
    if (IN(PH_INPROJ)) { if (!cv_early) CVSL(0, 0, 45); } SEAM(PH_INPROJ);
    if (IN(PH_SSM)) { if (cv_early) CVSL(0, 45, 70); }
    if (IN(PH_SSM)) { ph_ssm(p, F); }
    if (IN(PH_SSM)) { if (!cv_early) CVSL(0, 45, 70); } SEAM(PH_SSM);
    if (IN(PH_GLU)) {
        SDense S{(const char*)(ws + WS_GY), (const char*)(ws + WS_WGLU_T), 32, 8, 0, 1, 1024, F.G, F.bid};
        EpiGlu E{(bf16*)(ws + WS_HEADS), p.mix_g, (float*)(ws + WS_RSP_SSM)};
        pg8::gemm_phase<EpiGlu, SDense, true, false>(F.lds, nullptr, 1024, S, E);
    } SEAM(PH_GLU);
    if (IN(PH_OUT)) { if (cv_early) CVSL(0, 70, 100); }
    if (IN(PH_OUT)) {
        SDense S{(const char*)(ws + WS_HEADS), (const char*)(ws + WS_WOUT_T), 32, 8, 0, 1, 2048, F.G, F.bid};
        EpiOut E{p.x, p.out, (const float*)(ws + WS_MOD), (const float*)(ws + WS_RSP_SSM), (float*)(ws + WS_RSP_X1)};
        pg8::gemm_phase<EpiOut, SDense, true, false>(F.lds, nullptr, 2048, S, E);
    }
    if (IN(PH_OUT)) { if (!cv_early) CVSL(0, 70, 100); } SEAM(PH_OUT);
    if (IN(PH_ROUTE)) { ph_route(p, F); } SEAM(PH_ROUTE);
    int cfirst = 0, ccount = 0;
    if (IN(PH_MOE1)) { moe_tables(p, F); moe1_conv_share(F, cfirst, ccount); if (cv_early) conv_slice(p, F, 1, cfirst, cfirst + ccount, NWAVES); }
    if (IN(PH_MOE1)) {
        SMoe<4, true> S{F.misc, ws, 2048, F.G, F.bid};
        EpiAct E{ws + WS_ACT};
        pg8::gemm_phase<EpiAct, SMoe<4, true>, true, true, true>(F.lds, (LAS unsigned*)(F.lds + MISC_OFF) + MW_TAB, 2048, S, E);
    }
    if (IN(PH_MOE1)) { if (!cv_early) conv_slice(p, F, 1, cfirst, cfirst + ccount, NWAVES); } SEAM(PH_MOE1);
    if (IN(PH_MOE2)) {
        if (!IN(PH_MOE1)) moe_tables(p, F);
        SMoe<8, false> S{F.misc, ws, 512, F.G, F.bid};
        EpiY E{ws + WS_YS};
        pg8::gemm_phase<EpiY, SMoe<8, false>, true, false, true>(F.lds, nullptr, 512, S, E);
    } SEAM(PH_MOE2);
    if (IN(PH_FINAL)) { if (!IN(PH_MOE1)) moe_tables(p, F); ph_final(p, F); }
#undef IN
#undef SEAM
#undef CVSL
}

extern "C" void kernel_launch(void* const* d_in, const int* in_sizes, int n_in, void* d_out, int out_size, void* d_ws, size_t ws_size, hipStream_t stream) {
    if (n_in != 31 || out_size != T * D || ws_size < WS_END) { fprintf(stderr, "kernel_launch: unexpected sizes n_in %d out %d ws %zu (need %zu)\n", n_in, out_size, ws_size, (size_t)WS_END); return; }
    static int grid = 0;
    if (grid == 0) {
        int dev = 0, cus = 0, per_cu = 0;
        if (hipGetDevice(&dev) != hipSuccess || hipDeviceGetAttribute(&cus, hipDeviceAttributeMultiprocessorCount, dev) != hipSuccess) { fprintf(stderr, "kernel_launch: device query failed\n"); grid = -1; return; }
        if (hipFuncSetAttribute((const void*)mk_fast, hipFuncAttributeMaxDynamicSharedMemorySize, LDS_BYTES) != hipSuccess) { fprintf(stderr, "kernel_launch: hipFuncSetAttribute failed\n"); grid = -1; return; }
        if (hipOccupancyMaxActiveBlocksPerMultiprocessor(&per_cu, (const void*)mk_fast, NWAVES * 64, LDS_BYTES) != hipSuccess || per_cu < 1) { fprintf(stderr, "kernel_launch: occupancy query says %d blocks/CU\n", per_cu); grid = -1; return; }
        grid = cus;
        fprintf(stderr, "kernel_launch: grid %d (occupancy query %d/CU)\n", grid, per_cu);
    }
    if (grid < 0) return;
    Args a{}; a.lo = 0; a.hi = PH_N;
    const float** f = (const float**)&a.p;
    for (int i = 0; i < 31; ++i) f[i] = (const float*)d_in[i];
    a.p.out = (float*)d_out; a.p.ws = (unsigned char*)d_ws;
    (void)hipMemsetAsync((char*)d_ws + CW_BAR * 4, 0, XCD_BAR_WORDS * 4, stream);
    hipLaunchKernelGGL(mk_fast, dim3(grid), dim3(NWAVES * 64), LDS_BYTES, stream, a);
}
```

```cpp
#include <hip/hip_runtime.h>
#include <cstdio>
#include <cstdint>

typedef unsigned short bf16;
__device__ __forceinline__ unsigned f2bf(float f) { unsigned u = __builtin_bit_cast(unsigned, f); return (u + 0x7fffu + ((u >> 16) & 1u)) >> 16; }
__device__ __forceinline__ float bf2f(bf16 h) { return __builtin_bit_cast(float, (unsigned)h << 16); }

constexpr int D = 2048, NB = 4, SEQ = 2048, T = NB * SEQ, CTXL = 256, TC = NB * CTXL, TR = T + TC;
constexpr int DS = 1024, NMOD = 6, NE = 64, TOPK = 8, DE = 512;
constexpr float EPS = 1e-6f;
constexpr size_t MiB = 1u << 20;
constexpr size_t WS_CTL = 0, CTL_ZERO = 2 * MiB;
constexpr size_t CW_CNT = 1024;
constexpr size_t WS_MOD = 1 * MiB;
constexpr size_t WS_POS = 2 * MiB;
constexpr size_t WS_WTS = 3 * MiB;
constexpr size_t WS_ROWS = 4 * MiB;
constexpr size_t WS_XN = 8 * MiB;
constexpr size_t WS_U = 44 * MiB;
constexpr size_t WS_BG = 62 * MiB;
constexpr size_t WS_Z = 78 * MiB;
constexpr size_t WS_GY = 94 * MiB;
constexpr size_t WS_HEADS = 110 * MiB;
constexpr size_t WS_ACT = 44 * MiB;
constexpr size_t WS_YS = 142 * MiB;
constexpr size_t WS_END = 944 * MiB;

struct P {
    const float *x, *c, *ctx, *c_ctx, *norm1_g, *norm2_g, *w_ada, *b_ada, *w_in, *lam_re, *lam_im, *b_re, *b_im, *c_re, *c_im, *log_dt,
        *ssm_d, *w_glu, *conv_w, *conv_b, *mix_g, *w_out, *router_w, *router_b, *e_gate, *e_up, *e_down, *s_gate, *s_up, *s_down, *final_g;
    float* out; unsigned char* ws;
};
__device__ __forceinline__ float siluf(float v) { return v / (1.f + __expf(-v)); }
__device__ __forceinline__ float sigmf(float v) { return 1.f / (1.f + __expf(-v)); }
__device__ __forceinline__ float gelu_tanh(float v) { const float u = 0.7978845608028654f * (v + 0.044715f * v * v * v); return 0.5f * v * (1.f + tanhf(u)); }


#define LAS __attribute__((address_space(3)))
#define XB_TMO      128
#define XB_XCNT(j)  (256  + 64 * (j))
#define XB_XSUB(j)  (1280 + 64 * (j))
#define XB_XGEN(j)  (2304 + 64 * (j))
#define XB_TOP      3328
#define XB_TOPGEN   3392
#define XCD_BAR_WORDS 3456
#define XB_SPIN_CAP (1u << 18)
constexpr size_t CW_BAR = 65536;
__device__ __forceinline__ unsigned xb_ld(unsigned* p)              { return __hip_atomic_load(p, __ATOMIC_RELAXED, __HIP_MEMORY_SCOPE_AGENT); }
__device__ __forceinline__ unsigned xb_add(unsigned* p, unsigned v) { return __hip_atomic_fetch_add(p, v, __ATOMIC_RELAXED, __HIP_MEMORY_SCOPE_AGENT); }
__device__ __forceinline__ unsigned xb_xcc_id() { return (unsigned)__builtin_amdgcn_s_getreg((3 << 11) | 20) & 0xFu; }
#define XB_SPIN(cond, bar) do { unsigned _sp = 0; while (cond) { __builtin_amdgcn_s_sleep(1); \
    if ((++_sp & 255u) == 0u) { if (xb_ld(&(bar)[XB_TMO])) break; if (_sp > XB_SPIN_CAP) { atomicAdd(&(bar)[XB_TMO], 1u); break; } } } } while (0)
struct XcdBarrier { unsigned* bar; unsigned x; volatile LAS unsigned* st; };
__device__ __forceinline__ XcdBarrier xcd_barrier_post(unsigned* bar, volatile LAS unsigned* st) {
    XcdBarrier b; b.bar = bar; b.x = xb_xcc_id(); b.st = st;
    if (threadIdx.x == 0) (void)xb_add(&bar[XB_XCNT(b.x)], 1u);
    return b;
}
__device__ __forceinline__ void xcd_barrier_complete(unsigned* bar, unsigned x, unsigned& nloc, unsigned& nx) {
    const unsigned G = gridDim.x * gridDim.y * gridDim.z;
    unsigned sum, cnt, mine, sp = 0u;
    for (;;) {
        sum = 0u; cnt = 0u; mine = 0u;
#pragma unroll
        for (unsigned j = 0; j < 16; ++j) { const unsigned c = xb_ld(&bar[XB_XCNT(j)]); sum += c; cnt += (c > 0u) ? 1u : 0u; mine = (j == x) ? c : mine; }
        if (sum == G) break;
        __builtin_amdgcn_s_sleep(1);
        if ((++sp & 255u) == 0u) { if (xb_ld(&bar[XB_TMO])) break; if (sp > XB_SPIN_CAP) { atomicAdd(&bar[XB_TMO], 1u); break; } }
    }
    nloc = mine > 0u ? mine : 1u; nx = cnt > 0u ? cnt : 1u;
}
__device__ __forceinline__ void xcd_barrier(const XcdBarrier& b) {
    asm volatile("s_waitcnt vmcnt(0)" ::: "memory");
    __syncthreads();
    if (threadIdx.x == 0) {
        unsigned* bar = b.bar;
        __builtin_amdgcn_s_waitcnt(0);
        unsigned nloc = b.st[0], nx = b.st[1];
        if (nloc == 0u) { xcd_barrier_complete(bar, b.x, nloc, nx); b.st[0] = nloc; b.st[1] = nx; }
        const unsigned old = xb_add(&bar[XB_XSUB(b.x)], 1u);
        const unsigned gen = old / nloc;
        if (old + 1u == (gen + 1u) * nloc) {
            __builtin_amdgcn_fence(__ATOMIC_RELEASE, "agent");
            asm volatile("s_waitcnt vmcnt(0)" ::: "memory");
            const unsigned og = xb_add(&bar[XB_TOP], 1u);
            const unsigned tg = og / nx;
            if (og + 1u == (tg + 1u) * nx) xb_add(&bar[XB_TOPGEN], 1u);
            else XB_SPIN(xb_ld(&bar[XB_TOPGEN]) == tg, bar);
            __builtin_amdgcn_fence(__ATOMIC_ACQUIRE, "agent");
            asm volatile("s_waitcnt vmcnt(0)" ::: "memory");
            xb_add(&bar[XB_XGEN(b.x)], 1u);
            asm volatile("s_waitcnt vmcnt(0)" ::: "memory");
        } else {
            XB_SPIN(xb_ld(&bar[XB_XGEN(b.x)]) == gen, bar);
            asm volatile("buffer_inv sc0\n\ts_waitcnt vmcnt(0)" ::: "memory");
        }
    }
    __syncthreads();
}

namespace pg8 {
#define PG8_LAS __attribute__((address_space(3)))
typedef unsigned short bf16_t;
typedef short bf16x8 __attribute__((ext_vector_type(8)));
typedef float f32x4 __attribute__((ext_vector_type(4)));
typedef unsigned u32x4 __attribute__((ext_vector_type(4)));
constexpr int BM = 256, BK = 64, HALF = 128, HTB = HALF * BK * 2  , STAGE_BYTES = 8 * HTB, NXCD = 8, WGM = 8;

__host__ __device__ __forceinline__ int lds_byte(int r, int c) { const int st = (r >> 4) * 2 + (c >> 5), rr = r & 15, cc = c & 31, ob = rr * 64 + cc * 2; return st * 1024 + (ob ^ (((ob >> 9) & 1) << 5)); }
__host__ __device__ __forceinline__ void stage_rc(int b, int& R, int& C) { const int st = b / 1024, sb = b % 1024, swz = sb ^ (((sb >> 9) & 1) << 5); R = (st >> 1) * 16 + swz / 64; C = (st & 1) * 32 + (swz % 64) / 2; }
__host__ __device__ __forceinline__ int perm32(int rho) { const int n = rho >> 4, i = rho & 15; return 8 * (i >> 2) + 4 * n + (i & 3); }

struct Unit { int pm, pn, e, arow, nv; };

__device__ __forceinline__ void static_tile(int L, int nM, int nN, int& pm, int& pn) {
    const int nwg = nM * nN; int wgid = L; { const int q = nwg / NXCD, r = nwg % NXCD, xcd = wgid % NXCD, off = wgid / NXCD; wgid = (xcd < r ? xcd * (q + 1) : r * (q + 1) + (xcd - r) * q) + off; }
    const int nig = WGM * nN, gid = wgid / nig, fm = gid * WGM, gsz = (nM - fm) < WGM ? (nM - fm) : WGM;
    pm = fm + ((wgid % nig) % gsz); pn = (wgid % nig) / gsz;
}
__device__ __forceinline__ unsigned cvt_pk_bf16(float lo, float hi) { unsigned r; asm volatile("v_cvt_pk_bf16_f32 %0, %1, %2" : "=v"(r) : "v"(lo), "v"(hi)); return r; }

struct ASrc { const char* p; int slot; };
typedef int v8i_t __attribute__((ext_vector_type(8))); typedef int v4i_t __attribute__((ext_vector_type(4)));
__device__ __forceinline__ v8i_t cat32(bf16x8 lo, bf16x8 hi) { const v4i_t a = __builtin_bit_cast(v4i_t, lo), b = __builtin_bit_cast(v4i_t, hi); return __builtin_shufflevector(a, b, 0, 1, 2, 3, 4, 5, 6, 7); }
template <class Epi, class Sched, bool ALIGN_EPI, bool GATHER, bool F8 = false>
__device__ __forceinline__ void gemm_phase(PG8_LAS unsigned char* lds, PG8_LAS unsigned* tab, const int K, const Sched& S, const Epi& E) {
    const int tid = threadIdx.x, wid = __builtin_amdgcn_readfirstlane(tid >> 6), lane = tid & 63, wr = wid >> 2, wc = wid & 3, fr = lane & 15, fq = lane >> 4;
    constexpr int EB = F8 ? 1 : 2;
    const int nt = K * EB / 128;
    unsigned voffA[2], voffB[2]; int RA[2]; unsigned CA2[2];
#pragma unroll
    for (int i = 0; i < 2; ++i) { int R, C; stage_rc(tid * 16 + i * 8192, R, C); const int Rb = Epi::PERM ? ((R & ~31) + perm32(R & 31)) : R;
        voffA[i] = (unsigned)(R * K * EB + C * 2); voffB[i] = (unsigned)(Rb * K * EB + C * 2); RA[i] = R; CA2[i] = (unsigned)C * 2u; }
    const size_t kstep = (size_t)(BK * 2);
    const size_t hstep = (size_t)HALF * K * EB;
    const unsigned ldsw = (unsigned)wid * 1024u;
    const int aoff = lds_byte(wr * 64 + fr, fq * 8), boff = lds_byte(wc * 32 + fr, fq * 8);
#define PG8_SA(b, h) (((b) * 2 + (h)) * HTB)
#define PG8_SB(b, h) ((4 + (b) * 2 + (h)) * HTB)
#define PG8_STAGE(bufoff, gbase, voff) do { _Pragma("unroll") for (int _i = 0; _i < 2; ++_i) \
        __builtin_amdgcn_global_load_lds((const unsigned*)((const char*)(gbase) + (voff)[_i]), (PG8_LAS unsigned*)(lds + (bufoff) + ldsw + _i * 8192), 16, 0, 0); } while (0)
#define PG8_STAGE_A(bufoff, src, h) do { if constexpr (GATHER) { _Pragma("unroll") for (int _i = 0; _i < 2; ++_i) { const unsigned _o = tab[(src).slot * 256 + (h) * 128 + RA[_i]] + CA2[_i]; \
        __builtin_amdgcn_global_load_lds((const unsigned*)((src).p + _o), (PG8_LAS unsigned*)(lds + (bufoff) + ldsw + _i * 8192), 16, 0, 0); } } \
        else { PG8_STAGE(bufoff, (src).p + (h) * hstep, voffA); } } while (0)
#define PG8_LDA(dst, b, h) do { if constexpr (F8) { _Pragma("unroll") for (int m = 0; m < 4; ++m) dst##8[m] = cat32(*(const PG8_LAS bf16x8*)(lds + PG8_SA(b, h) + aoff + m * 2048), *(const PG8_LAS bf16x8*)(lds + PG8_SA(b, h) + aoff + m * 2048 + 1024)); } \
        else { _Pragma("unroll") for (int m = 0; m < 4; ++m) _Pragma("unroll") for (int k = 0; k < 2; ++k) dst[m][k] = *(const PG8_LAS bf16x8*)(lds + PG8_SA(b, h) + aoff + m * 2048 + k * 1024); } } while (0)
#define PG8_LDB(dst, b, h) do { if constexpr (F8) { _Pragma("unroll") for (int n = 0; n < 2; ++n) dst##8[n] = cat32(*(const PG8_LAS bf16x8*)(lds + PG8_SB(b, h) + boff + n * 2048), *(const PG8_LAS bf16x8*)(lds + PG8_SB(b, h) + boff + n * 2048 + 1024)); } \
        else { _Pragma("unroll") for (int n = 0; n < 2; ++n) _Pragma("unroll") for (int k = 0; k < 2; ++k) dst[n][k] = *(const PG8_LAS bf16x8*)(lds + PG8_SB(b, h) + boff + n * 2048 + k * 1024); } } while (0)
#define PG8_MMA(ai, bj, At, Bt) do { __builtin_amdgcn_s_setprio(1); if constexpr (F8) { _Pragma("unroll") for (int m = 0; m < 4; ++m) _Pragma("unroll") for (int n = 0; n < 2; ++n) \
        asm volatile("v_mfma_f32_16x16x128_f8f6f4 %0, %1, %2, %0" : "+v"(acc[ai][bj][m][n]) : "v"(Bt##8[n]), "v"(At##8[m])); }     \
        else { _Pragma("unroll") for (int m = 0; m < 4; ++m) _Pragma("unroll") for (int n = 0; n < 2; ++n) _Pragma("unroll") for (int k = 0; k < 2; ++k) \
        acc[ai][bj][m][n] = __builtin_amdgcn_mfma_f32_16x16x32_bf16(Bt[n][k], At[m][k], acc[ai][bj][m][n], 0, 0, 0); } __builtin_amdgcn_s_setprio(0); } while (0)
#define PG8_WAIT_V(n) asm volatile("s_waitcnt vmcnt(" #n ")" ::: "memory")
#define PG8_WAIT_L(n) asm volatile("s_waitcnt lgkmcnt(" #n ")" ::: "memory")
#define PG8_BAR __builtin_amdgcn_s_barrier()
#define PG8_SCHED __builtin_amdgcn_sched_barrier(0)
    Unit cur, nxt; int ui = 0;
    if (!S.next(0, cur)) return;
    f32x4 acc[2][2][4][2];
#pragma unroll
    for (int a = 0; a < 2; ++a)
#pragma unroll
        for (int b = 0; b < 2; ++b)
#pragma unroll
            for (int m = 0; m < 4; ++m)
#pragma unroll
                for (int n = 0; n < 2; ++n) acc[a][b][m][n] = (f32x4){0.f, 0.f, 0.f, 0.f};
    bf16x8 At[4][2], B0[2][2], B1[2][2];
    v8i_t At8[4], B08[2], B18[2];
    ASrc cA; cA.slot = 0; const char* cB = S.b_ptr(cur);
    if constexpr (GATHER) { cA.p = S.a_base(); S.fill_rows(cur, tab); PG8_WAIT_L(0); PG8_BAR; } else { cA.p = S.a_ptr(cur); }
    {
        ASrc c1 = cA; c1.p += kstep;
        PG8_STAGE(PG8_SB(0, 0), cB, voffB); PG8_STAGE(PG8_SB(0, 1), cB + hstep, voffB); PG8_STAGE_A(PG8_SA(0, 0), cA, 0); PG8_STAGE_A(PG8_SA(0, 1), cA, 1);
        if (wr == 1) PG8_BAR;
        PG8_WAIT_V(2); PG8_BAR;
        PG8_STAGE(PG8_SB(1, 0), cB + kstep, voffB); PG8_STAGE_A(PG8_SA(1, 0), c1, 0); PG8_STAGE(PG8_SB(1, 1), cB + hstep + kstep, voffB);
        PG8_WAIT_V(6); PG8_BAR;
    }
    for (;;) {
        const bool has_next = S.next(ui + 1, nxt);
        ASrc nA = cA; const char* nB = cB;
        if (has_next) { nB = S.b_ptr(nxt); if constexpr (GATHER) { nA.slot = cA.slot ^ 1; S.fill_rows(nxt, tab + nA.slot * 256); } else { nA.p = S.a_ptr(nxt); } }
        for (int t = 0; t < nt; t += 2) {
            const bool last = (t == nt - 2);
            if constexpr (Epi::MIDK) { if (t == nt / 2) E.midk(acc, cur, wr, fr); }
            ASrc a1 = cA; a1.p += (size_t)(t + 1) * kstep;
            ASrc a2 = cA; a2.p += (size_t)(t + 2) * kstep; if (last) a2 = nA;
            const char* b2 = last ? nB : cB + (size_t)(t + 2) * kstep;
            ASrc a3 = a2; a3.p += kstep; const char* b3 = b2 + kstep;
            PG8_LDB(B0, 0, 0); PG8_LDB(B1, 0, 1); PG8_SCHED; PG8_LDA(At, 0, 0); PG8_STAGE_A(PG8_SA(1, 1), a1, 1);
            PG8_WAIT_V(8); PG8_WAIT_L(0); PG8_BAR; PG8_MMA(0, 0, At, B0); PG8_MMA(0, 1, At, B1); PG8_BAR; PG8_SCHED;
            PG8_LDA(At, 0, 1); PG8_STAGE(PG8_SB(0, 0), b2, voffB); PG8_STAGE(PG8_SB(0, 1), b2 + hstep, voffB); PG8_STAGE_A(PG8_SA(0, 0), a2, 0);
            PG8_WAIT_V(8); PG8_WAIT_L(0); PG8_BAR; PG8_MMA(1, 0, At, B0); PG8_MMA(1, 1, At, B1); PG8_BAR; PG8_SCHED;
            PG8_LDB(B0, 1, 0); PG8_LDB(B1, 1, 1); PG8_SCHED; PG8_LDA(At, 1, 0); PG8_STAGE_A(PG8_SA(0, 1), a2, 1);
            PG8_WAIT_V(8); PG8_WAIT_L(0); PG8_BAR; PG8_MMA(0, 0, At, B0); PG8_MMA(0, 1, At, B1); PG8_BAR; PG8_SCHED;
            PG8_LDA(At, 1, 1); PG8_STAGE(PG8_SB(1, 0), b3, voffB); PG8_STAGE(PG8_SB(1, 1), b3 + hstep, voffB); PG8_STAGE_A(PG8_SA(1, 0), a3, 0);
            PG8_WAIT_V(8); PG8_WAIT_L(0); PG8_BAR; PG8_MMA(1, 0, At, B0); PG8_MMA(1, 1, At, B1); PG8_BAR; PG8_SCHED;
        }
        if constexpr (ALIGN_EPI) { if (wr == 0) PG8_BAR; }
        if constexpr (F8) asm volatile("s_nop 15\n\ts_nop 15" ::: "memory");
        if constexpr (Epi::DRAIN) { if (has_next) E(acc, cur, wr, wc, fr, fq); } else E(acc, cur, wr, wc, fr, fq);
        if (!has_next) break;
#pragma unroll
        for (int a = 0; a < 2; ++a)
#pragma unroll
            for (int b = 0; b < 2; ++b)
#pragma unroll
                for (int m = 0; m < 4; ++m)
#pragma unroll
                    for (int n = 0; n < 2; ++n) acc[a][b][m][n] = (f32x4){0.f, 0.f, 0.f, 0.f};
        cur = nxt; cA = nA; cB = nB; ++ui;
        if constexpr (ALIGN_EPI) { if (wr == 1) PG8_BAR; }
    }
    PG8_WAIT_V(0);
    if constexpr (!ALIGN_EPI) { if (wr == 0) PG8_BAR; }
    PG8_BAR;
    if constexpr (Epi::DRAIN) E.fused(acc, cur, wr, wc, fr, fq, lds);
#undef PG8_SA
#undef PG8_SB
#undef PG8_STAGE
#undef PG8_STAGE_A
#undef PG8_LDA
#undef PG8_LDB
#undef PG8_MMA
#undef PG8_WAIT_V
#undef PG8_WAIT_L
#undef PG8_BAR
#undef PG8_SCHED
}
}
constexpr int NWAVES = 8;
constexpr size_t WS_WRT_HI = 2 * MiB + 256 * 1024, WS_WRT_LO = 2 * MiB + 512 * 1024;
constexpr size_t WS_XN8 = WS_XN;
constexpr size_t WS_RSP_SSM = 6 * MiB, WS_RSP_X1 = 7 * MiB;
constexpr size_t WS_WIN_T = 494 * MiB;
constexpr size_t WS_WGLU_T = 510 * MiB;
constexpr size_t WS_WOUT_T = 514 * MiB;
constexpr size_t WS_WS1_T = 522 * MiB;
constexpr size_t WS_WS2_T = 526 * MiB;
constexpr size_t WS_WE1_T = 528 * MiB;
constexpr size_t WS_WE2_T = 784 * MiB;
static_assert(WS_WE2_T + 64 * 2 * MiB == 912 * MiB, "ws map");
constexpr size_t WS_X1B = 912 * MiB;
constexpr int RING_BYTES = 131072, MISC_OFF = 155 * 1024, LDS_BYTES = 160 * 1024;
constexpr int MW_BAR = 0, MW_TILES = 16, MW_UPRE = 96, MW_SEG = 176, MW_TAB = 256, MW_CAP = 768, MW_SBASE = 848, MW_UL = 960;
typedef pg8::f32x4 f32x4; typedef pg8::u32x4 u32x4;
typedef unsigned u32x2 __attribute__((ext_vector_type(2)));
typedef short bf16x8v __attribute__((ext_vector_type(8)));

struct Fr { LAS unsigned char* lds; volatile LAS unsigned* misc; int tid, lane, wave, G, bid; };

struct SDense {
    const char* A; const char* Bt; int nM, nN, extra, exN, K, G, c;
    __device__ __forceinline__ bool next(int i, pg8::Unit& u) const { const int L = i * G + c, nwg = nM * nN; if (L >= nwg + extra) return false;
        if (L < nwg) pg8::static_tile(L, nM, nN, u.pm, u.pn); else { const int r = L - nwg; u.pm = nM + r / exN; u.pn = r % exN; } u.e = 0; u.arow = u.pm * 256; u.nv = 256; return true; }
    __device__ __forceinline__ const char* a_ptr(const pg8::Unit& u) const { return A + (size_t)u.pm * 256 * K * 2; }
    __device__ __forceinline__ const char* b_ptr(const pg8::Unit& u) const { return Bt + (size_t)u.pn * 256 * K * 2; }
};
template <int NPN, bool PN_OUTER> struct SMoe {
    const volatile LAS unsigned* misc; const unsigned char* ws; int K, G, c;
    __device__ __forceinline__ void build_list() const { const int t = threadIdx.x;
        if (t < 16) { pg8::Unit u; const bool ok = slow_next(t, u); LAS unsigned* q = (LAS unsigned*)misc + MW_UL + 4 * t; q[0] = ok ? ((unsigned)u.pm | ((unsigned)u.nv << 16)) : 0xffffffffu; q[1] = (unsigned)u.pn; q[2] = (unsigned)u.e; q[3] = (unsigned)u.arow; }
        __syncthreads(); }
    __device__ __forceinline__ bool next(int i, pg8::Unit& u) const {
        if (i >= 16) return slow_next(i, u);
        const u32x4 q = *(const LAS u32x4*)((const LAS unsigned*)misc + MW_UL + 4 * i);
        u.pm = (int)(q[0] & 0xffffu); u.nv = (int)(q[0] >> 16); u.pn = (int)q[1]; u.e = (int)q[2]; u.arow = (int)q[3]; return q[0] != 0xffffffffu; }
    __device__ __forceinline__ bool slow_next(int i, pg8::Unit& u) const {
        const int ntot = (int)misc[MW_UPRE + 65] * NPN, chunk = (ntot + 7) >> 3, x = c & 7, j = c >> 3, w = i * 32 + j;
        const int L = x * chunk + w; if (w >= chunk || L >= ntot) return false;
        int gi = 0;
        for (int s = 64; s > 0; s >>= 1) { const int t = gi + s; if (t <= 64 && (int)misc[MW_UPRE + t] * NPN <= L) gi = t; }
        const int rem = L - (int)misc[MW_UPRE + gi] * NPN, tl = (int)misc[MW_TILES + gi];
        if (PN_OUTER) { u.pn = rem / tl; u.pm = rem % tl; } else { u.pm = rem / NPN; u.pn = rem % NPN; }
        u.e = gi; u.arow = (int)misc[MW_SEG + gi] + u.pm * 256; { const int left = (int)misc[MW_CAP + gi] - u.pm * 256; u.nv = left < 256 ? left : 256; } return true; }
    __device__ __forceinline__ const char* a_base() const { return (const char*)(ws + WS_XN8); }
    __device__ __forceinline__ void fill_rows(const pg8::Unit& u, LAS unsigned* slot) const { const int t = threadIdx.x;
        if (t < 256) { const unsigned tok = u.e < 64 ? (unsigned)((const int*)(ws + WS_ROWS))[u.e * 8192 + u.pm * 256 + t] : (unsigned)(u.pm * 256 + t); slot[t] = tok * (unsigned)D; } }
    __device__ __forceinline__ const char* a_ptr(const pg8::Unit& u) const { return (const char*)(ws + WS_ACT) + (size_t)u.arow * K; }
    __device__ __forceinline__ const char* b_ptr(const pg8::Unit& u) const {
        if (NPN == 4) return (const char*)(ws + (u.e < 64 ? WS_WE1_T + (size_t)u.e * 4 * MiB : WS_WS1_T)) + (size_t)u.pn * 256 * K;
        return (const char*)(ws + (u.e < 64 ? WS_WE2_T + (size_t)u.e * 2 * MiB : WS_WS2_T)) + (size_t)u.pn * 256 * K; }
};

__device__ __forceinline__ u32x4 pack8(const f32x4 a, const f32x4 b) { u32x4 w; w.x = pg8::cvt_pk_bf16(a[0], a[1]); w.y = pg8::cvt_pk_bf16(a[2], a[3]); w.z = pg8::cvt_pk_bf16(b[0], b[1]); w.w = pg8::cvt_pk_bf16(b[2], b[3]); return w; }
__device__ __forceinline__ float gelu_fast(float v) { const float u2 = 1.5957691216057308f * (v + 0.044715f * v * v * v); return v * __builtin_amdgcn_rcpf(1.f + __expf(-u2)); }
__device__ __forceinline__ float clamp8(float v) { return __builtin_amdgcn_fmed3f(v, -440.f, 440.f); }
__device__ __forceinline__ unsigned pk4_fp8(float a, float b, float c, float d) { a = clamp8(a); b = clamp8(b); c = clamp8(c); d = clamp8(d); int w = 0; w = __builtin_amdgcn_cvt_pk_fp8_f32(a, b, w, false); w = __builtin_amdgcn_cvt_pk_fp8_f32(c, d, w, true); return (unsigned)w; }
__device__ __forceinline__ float fsig(float v) { return __builtin_amdgcn_rcpf(1.f + __expf(-v)); }
struct EpiInProj { static constexpr bool PERM = true, MIDK = false, DRAIN = false;
    bf16 *U, *BG, *Z;
    __device__ __forceinline__ void operator()(const f32x4 (&acc)[2][2][4][2], const pg8::Unit& u, int wr, int wc, int fr, int fq) const {
        const int row0 = u.pm * 256 + wr * 64 + fr, cw = wc * 32 + 8 * fq;
        if (u.pn < 8) { bf16* O = (u.pn < 4 ? U : BG) + (u.pn & 3) * 256 + cw;
#pragma unroll
            for (int ai = 0; ai < 2; ++ai)
#pragma unroll
                for (int m = 0; m < 4; ++m) { bf16* rp = O + (size_t)(row0 + ai * 128 + m * 16) * DS;
#pragma unroll
                    for (int bj = 0; bj < 2; ++bj) *(u32x4*)(rp + bj * 128) = pack8(acc[ai][bj][m][0], acc[ai][bj][m][1]); }
        } else { bf16* O = Z + (u.pn - 8) * 128 + cw;
#pragma unroll
            for (int ai = 0; ai < 2; ++ai)
#pragma unroll
                for (int m = 0; m < 4; ++m) *(u32x4*)(O + (size_t)(row0 + ai * 128 + m * 16) * DS) = pack8(acc[ai][0][m][0] * acc[ai][1][m][0], acc[ai][0][m][1] * acc[ai][1][m][1]); }
    }
};
struct EpiGlu { static constexpr bool PERM = true, MIDK = false, DRAIN = false;
    bf16* HEADS; const float* mix_g; float* rs;
    __device__ __forceinline__ void operator()(const f32x4 (&acc)[2][2][4][2], const pg8::Unit& u, int wr, int wc, int fr, int fq) const {
        const int row0 = u.pm * 256 + wr * 64 + fr, col = u.pn * 128 + wc * 32 + 8 * fq;
        const f32x4 g0 = *(const f32x4*)(mix_g + col), g1 = *(const f32x4*)(mix_g + col + 4);
#pragma unroll
        for (int ai = 0; ai < 2; ++ai)
#pragma unroll
            for (int m = 0; m < 4; ++m) { const int row = row0 + ai * 128 + m * 16; f32x4 s0, s1; float ss = 0.f;
#pragma unroll
                for (int e = 0; e < 4; ++e) { s0[e] = acc[ai][0][m][0][e] * fsig(acc[ai][1][m][0][e]); s1[e] = acc[ai][0][m][1][e] * fsig(acc[ai][1][m][1][e]); ss += s0[e] * s0[e] + s1[e] * s1[e]; }
                ss += __shfl_xor(ss, 16); ss += __shfl_xor(ss, 32);
                if (fq == 0) rs[row * 32 + u.pn * 4 + wc] = ss;
                *(u32x4*)(HEADS + (size_t)row * D + col) = pack8(s0 * g0, s1 * g1); }
    }
};
struct EpiOut { static constexpr bool PERM = false, MIDK = true, DRAIN = true;
    const float* x; bf16* x1; const float* mod; const float* rs_ssm; float* rs_x1;
    __device__ __forceinline__ void midk(f32x4 (&acc)[2][2][4][2], const pg8::Unit& u, int wr, int fr) const {
#pragma unroll
        for (int ai = 0; ai < 2; ++ai)
#pragma unroll
            for (int m = 0; m < 4; ++m) { const f32x4* pr = (const f32x4*)(rs_ssm + (size_t)(u.pm * 256 + ai * 128 + wr * 64 + m * 16 + fr) * 32); f32x4 s4 = pr[0];
#pragma unroll
                for (int j = 1; j < 8; ++j) s4 += pr[j];
                const float f = rsqrtf(((s4[0] + s4[1]) + (s4[2] + s4[3])) * (1.f / 1024.f) + EPS);
#pragma unroll
                for (int bj = 0; bj < 2; ++bj)
#pragma unroll
                    for (int n = 0; n < 2; ++n) acc[ai][bj][m][n] *= f; }
    }
    __device__ __forceinline__ void operator()(const f32x4 (&acc)[2][2][4][2], const pg8::Unit& u, int wr, int wc, int fr, int fq) const {
        const int row0 = u.pm * 256 + wr * 64 + fr, col0 = u.pn * 256 + wc * 32 + 4 * fq; const float* g1 = mod + (u.pm >> 3) * 12288 + 2 * 2048;
#pragma unroll
        for (int ai = 0; ai < 2; ++ai)
#pragma unroll
            for (int m = 0; m < 4; ++m) { const int row = row0 + ai * 128 + m * 16; float ss = 0.f;
#pragma unroll
                for (int bj = 0; bj < 2; ++bj)
#pragma unroll
                    for (int n = 0; n < 2; ++n) { const int col = col0 + bj * 128 + n * 16; const f32x4 xv = __builtin_nontemporal_load((const f32x4*)(x + (size_t)row * D + col)), gv = *(const f32x4*)(g1 + col);
                        const f32x4 o = xv + gv * acc[ai][bj][m][n]; ss += (o[0] * o[0] + o[1] * o[1]) + (o[2] * o[2] + o[3] * o[3]); { u32x2 ob; ob.x = pg8::cvt_pk_bf16(o[0], o[1]); ob.y = pg8::cvt_pk_bf16(o[2], o[3]); *(u32x2*)(x1 + (size_t)row * D + col) = ob; } }
                ss += __shfl_xor(ss, 16); ss += __shfl_xor(ss, 32);
                if (fq == 0) rs_x1[row * 32 + u.pn * 4 + wc] = ss; }
    }
    __device__ __forceinline__ void fused(const f32x4 (&acc)[2][2][4][2], const pg8::Unit& u, int wr, int wc, int fr, int fq, LAS unsigned char* lds) const {
        const int tid = threadIdx.x, lane = tid & 63, col0 = u.pn * 256 + wc * 32 + 4 * fq; const float* g1 = mod + (u.pm >> 3) * 12288 + 2 * 2048;
        f32x4 gv[2][2];
#pragma unroll
        for (int bj = 0; bj < 2; ++bj)
#pragma unroll
            for (int n = 0; n < 2; ++n) gv[bj][n] = *(const f32x4*)(g1 + col0 + bj * 128 + n * 16);
#pragma unroll 1
        for (int ai = 0; ai < 2; ++ai) {
#pragma unroll
            for (int i = 0; i < 16; ++i) { const int r = (tid >> 6) + 8 * i, c = lane ^ (r & 15);
                __builtin_amdgcn_global_load_lds((const unsigned*)(x + (size_t)(u.pm * 256 + ai * 128 + r) * D + u.pn * 256 + c * 4), (LAS unsigned*)(lds + ((tid & ~63) + 512 * i) * 16), 16, 0, 2); }
            asm volatile("s_waitcnt vmcnt(0)" ::: "memory"); __builtin_amdgcn_s_barrier(); asm volatile("" ::: "memory");
#pragma unroll
            for (int m = 0; m < 4; ++m) { const int rl = wr * 64 + m * 16 + fr, row = u.pm * 256 + ai * 128 + rl; float ss = 0.f;
#pragma unroll
                for (int bj = 0; bj < 2; ++bj)
#pragma unroll
                    for (int n = 0; n < 2; ++n) { const int col = col0 + bj * 128 + n * 16, slot = (bj * 32 + wc * 8 + n * 4 + fq) ^ (rl & 15);
                        const f32x4 xv = *(const LAS f32x4*)(lds + (rl * 64 + slot) * 16);
                        const f32x4 a = ai == 0 ? acc[0][bj][m][n] : acc[1][bj][m][n];
                        const f32x4 o = xv + gv[bj][n] * a; ss += (o[0] * o[0] + o[1] * o[1]) + (o[2] * o[2] + o[3] * o[3]); { u32x2 ob; ob.x = pg8::cvt_pk_bf16(o[0], o[1]); ob.y = pg8::cvt_pk_bf16(o[2], o[3]); *(u32x2*)(x1 + (size_t)row * D + col) = ob; } }
                ss += __shfl_xor(ss, 16); ss += __shfl_xor(ss, 32);
                if (fq == 0) rs_x1[row * 32 + u.pn * 4 + wc] = ss; }
            asm volatile("s_waitcnt lgkmcnt(0)" ::: "memory"); __builtin_amdgcn_s_barrier(); asm volatile("" ::: "memory");
        }
    }
};
struct EpiAct { static constexpr bool PERM = true, MIDK = false, DRAIN = false;
    unsigned char* ACT;
    __device__ __forceinline__ void operator()(const f32x4 (&acc)[2][2][4][2], const pg8::Unit& u, int wr, int wc, int fr, int fq) const {
        unsigned char* O = ACT + (size_t)(u.arow + wr * 64 + fr) * DE + u.pn * 128 + wc * 32 + 8 * fq;
#pragma unroll
        for (int ai = 0; ai < 2; ++ai)
#pragma unroll
            for (int m = 0; m < 4; ++m) { f32x4 s0, s1;
#pragma unroll
                for (int e = 0; e < 4; ++e) { const float g0 = acc[ai][0][m][0][e] * 0.00390625f, g1 = acc[ai][0][m][1][e] * 0.00390625f;
                    s0[e] = 0.0625f * g0 * fsig(g0) * acc[ai][1][m][0][e]; s1[e] = 0.0625f * g1 * fsig(g1) * acc[ai][1][m][1][e]; }
                u32x2 o; o.x = pk4_fp8(s0[0], s0[1], s0[2], s0[3]); o.y = pk4_fp8(s1[0], s1[1], s1[2], s1[3]);
                if (ai * 128 + wr * 64 + m * 16 + fr < u.nv) *(u32x2*)(O + (size_t)(ai * 128 + m * 16) * DE) = o; }
    }
};
struct EpiY { static constexpr bool PERM = true, MIDK = false, DRAIN = false;
    unsigned char* YS;
    __device__ __forceinline__ void operator()(const f32x4 (&acc)[2][2][4][2], const pg8::Unit& u, int wr, int wc, int fr, int fq) const {
        unsigned char* O = YS + (size_t)(u.arow + wr * 64 + fr) * D + (u.pn * 16 + wc * 4 + fq) * 16;
#pragma unroll
        for (int ai = 0; ai < 2; ++ai)
#pragma unroll
            for (int m = 0; m < 4; ++m) { const f32x4 a0 = acc[ai][0][m][0] * 0.0625f, a1 = acc[ai][0][m][1] * 0.0625f, b0 = acc[ai][1][m][0] * 0.0625f, b1 = acc[ai][1][m][1] * 0.0625f;
                u32x4 o; o.x = pk4_fp8(a0[0], a0[1], a0[2], a0[3]); o.y = pk4_fp8(a1[0], a1[1], a1[2], a1[3]); o.z = pk4_fp8(b0[0], b0[1], b0[2], b0[3]); o.w = pk4_fp8(b1[0], b1[1], b1[2], b1[3]);
                if (ai * 128 + wr * 64 + m * 16 + fr < u.nv) *(u32x4*)(O + (size_t)(ai * 128 + m * 16) * D) = o; }
    }
};

__device__ __forceinline__ unsigned pk2(float lo, float hi) { unsigned r; asm("v_cvt_pk_bf16_f32 %0, %1, %2" : "=v"(r) : "v"(lo), "v"(hi)); return r; }
struct CvItem { const float* W; bf16* WT; int K, N, k0, n0, rowbase, f8; };
__device__ __forceinline__ int pair_row(int n, int half) { return 256 * (n >> 7) + 128 * half + (n & 127); }
constexpr int CV_IN = 32 * 128, CV_GLU = 16 * 64, CV_OUT = 32 * 64, CV_S = 512, CV_E = 512;
constexpr int CV_TOTAL = CV_IN + CV_GLU + CV_OUT + 3 * CV_S + 64 * 3 * CV_E;
__device__ __forceinline__ CvItem cv_decode(const P& p, int it) {
    unsigned char* ws = p.ws; CvItem c;
    if (it < CV_IN) { const int kb = it / 128, nb = it % 128, n0 = nb * 32; int rb; if (n0 < 2048) rb = n0; else if (n0 < 3072) rb = 2048 + pair_row(n0 - 2048, 0); else rb = 2048 + pair_row(n0 - 3072, 1);
        c.W = p.w_in; c.WT = (bf16*)(ws + WS_WIN_T); c.K = 2048; c.N = 4096; c.k0 = kb * 64; c.n0 = n0; c.rowbase = rb; c.f8 = 0; return c; }
    it -= CV_IN;
    if (it < CV_GLU) { const int kb = it / 64, nb = it % 64, n0 = nb * 32;
        c.W = p.w_glu; c.WT = (bf16*)(ws + WS_WGLU_T); c.K = 1024; c.N = 2048; c.k0 = kb * 64; c.n0 = n0; c.rowbase = n0 < 1024 ? pair_row(n0, 0) : pair_row(n0 - 1024, 1); c.f8 = 0; return c; }
    it -= CV_GLU;
    if (it < CV_OUT) { const int kb = it / 64, nb = it % 64; c.W = p.w_out; c.WT = (bf16*)(ws + WS_WOUT_T); c.K = 2048; c.N = 2048; c.k0 = kb * 64; c.n0 = nb * 32; c.rowbase = nb * 32; c.f8 = 0; return c; }
    it -= CV_OUT;
    int e = 64;
    if (it >= 3 * CV_S) { it -= 3 * CV_S; e = it / (3 * CV_E); it -= e * 3 * CV_E; }
    const int which = it / 512, r = it % 512;
    if (which < 2) { c.W = e < 64 ? (which == 0 ? p.e_gate : p.e_up) + (size_t)e * D * DE : (which == 0 ? p.s_gate : p.s_up);
        c.WT = (bf16*)(ws + (e < 64 ? WS_WE1_T + (size_t)e * 4 * MiB : WS_WS1_T)); const int kb = r / 16, nb = r % 16;
        c.K = 2048; c.N = 512; c.k0 = kb * 64; c.n0 = nb * 32; c.rowbase = pair_row(nb * 32, which);
    } else { c.W = e < 64 ? p.e_down + (size_t)e * DE * D : p.s_down; c.WT = (bf16*)(ws + (e < 64 ? WS_WE2_T + (size_t)e * 2 * MiB : WS_WS2_T)); const int kb = r / 64, nb = r % 64;
        c.K = 512; c.N = 2048; c.k0 = kb * 64; c.n0 = nb * 32; c.rowbase = nb * 32; }
    c.f8 = 1;
    return c;
}
__device__ __forceinline__ void cv_load(const CvItem& c, float (&r)[32], int lane) {
    const float* src = c.W + (size_t)(c.k0 + (lane >> 5)) * c.N + c.n0 + (lane & 31);
#pragma unroll
    for (int i = 0; i < 32; ++i) r[i] = __builtin_nontemporal_load(src + (size_t)(2 * i) * c.N);
}
__device__ __forceinline__ void cv_finish(const CvItem& c, const float (&r)[32], LAS float* scr, int lane) {
#pragma unroll
    for (int i = 0; i < 32; ++i) scr[(2 * i + (lane >> 5)) * 33 + (lane & 31)] = r[i];
    asm volatile("s_waitcnt lgkmcnt(0)" ::: "memory");
    const int cc = lane & 7;
#pragma unroll
    for (int j = 0; j < 4; ++j) { const int n = (lane >> 3) + 8 * j; const LAS float* s = scr + (8 * cc) * 33 + n;
        if (c.f8) { u32x2 o; o.x = pk4_fp8(16.f * s[0 * 33], 16.f * s[1 * 33], 16.f * s[2 * 33], 16.f * s[3 * 33]); o.y = pk4_fp8(16.f * s[4 * 33], 16.f * s[5 * 33], 16.f * s[6 * 33], 16.f * s[7 * 33]);
            *(u32x2*)((unsigned char*)c.WT + (size_t)(c.rowbase + n) * c.K + c.k0 + 8 * cc) = o; }
        else { u32x4 o; o.x = pg8::cvt_pk_bf16(s[0 * 33], s[1 * 33]); o.y = pg8::cvt_pk_bf16(s[2 * 33], s[3 * 33]); o.z = pg8::cvt_pk_bf16(s[4 * 33], s[5 * 33]); o.w = pg8::cvt_pk_bf16(s[6 * 33], s[7 * 33]);
            *(u32x4*)(c.WT + (size_t)(c.rowbase + n) * c.K + c.k0 + 8 * cc) = o; } }
    asm volatile("s_waitcnt lgkmcnt(0)" ::: "memory");
}

constexpr int CVB_E = 768;
constexpr int CVS_UP = 65 * 512, CVS_DOWN = 65 * 256;
struct CvBig { const float* src; unsigned char* dst; int N, K; };
__device__ __forceinline__ CvBig cvb_decode(const P& p, int set, int j, int lane) {
    unsigned char* ws = p.ws; const int e = set == 0 ? j >> 9 : j >> 8, which = set == 0 ? (j >> 8) & 1 : 2, s = j & 255;
    const float* W; unsigned char* WT; int K, N, k0, n0, rowbase;
    if (which < 2) { W = e < 64 ? (which == 0 ? p.e_gate : p.e_up) + (size_t)e * D * DE : (which == 0 ? p.s_gate : p.s_up); WT = ws + (e < 64 ? WS_WE1_T + (size_t)e * 4 * MiB : WS_WS1_T);
        K = 2048; N = 512; k0 = (s >> 4) * 128; n0 = (s & 15) * 32; rowbase = pair_row(n0, which); }
    else { W = e < 64 ? p.e_down + (size_t)e * DE * D : p.s_down; WT = ws + (e < 64 ? WS_WE2_T + (size_t)e * 2 * MiB : WS_WS2_T); K = 512; N = 2048; k0 = (s >> 6) * 128; n0 = (s & 63) * 32; rowbase = n0; }
    CvBig c; c.src = W + (size_t)(k0 + (lane >> 3)) * N + n0 + 4 * (lane & 7); c.dst = WT + (size_t)(rowbase + (lane >> 3)) * K + k0 + 16 * (lane & 7); c.N = N; c.K = K; return c;
}
__device__ __forceinline__ void cvb_load(const CvBig& c, f32x4 (&rr)[16]) {
#pragma unroll
    for (int i = 0; i < 16; ++i) rr[i] = __builtin_nontemporal_load((const f32x4*)(c.src + (size_t)(8 * i) * c.N));
}
__device__ __forceinline__ void cvb_finish(const CvBig& c, const f32x4 (&rr)[16], LAS float* scr, int lane) {
#pragma unroll
    for (int i = 0; i < 16; ++i) { LAS float* d = scr + (8 * i + (lane >> 3)) * 33 + 4 * (lane & 7); d[0] = rr[i][0]; d[1] = rr[i][1]; d[2] = rr[i][2]; d[3] = rr[i][3]; }
    asm volatile("s_waitcnt lgkmcnt(0)" ::: "memory");
    const int cc = lane & 7;
#pragma unroll
    for (int j = 0; j < 4; ++j) { const int n = (lane >> 3) + 8 * j; const LAS float* sp = scr + (16 * cc) * 33 + n; u32x4 o;
#pragma unroll
        for (int d = 0; d < 4; ++d) o[d] = pk4_fp8(16.f * sp[(4 * d) * 33], 16.f * sp[(4 * d + 1) * 33], 16.f * sp[(4 * d + 2) * 33], 16.f * sp[(4 * d + 3) * 33]);
        __builtin_nontemporal_store(o, (u32x4*)(c.dst + (size_t)(8 * j) * c.K)); }
    asm volatile("s_waitcnt lgkmcnt(0)" ::: "memory");
}
__device__ __forceinline__ float wave_sum(float v) {
    v += __builtin_bit_cast(float, __builtin_amdgcn_update_dpp(0, __builtin_bit_cast(int, v), 0xB1, 0xf, 0xf, true));
    v += __builtin_bit_cast(float, __builtin_amdgcn_update_dpp(0, __builtin_bit_cast(int, v), 0x4E, 0xf, 0xf, true));
    v += __builtin_bit_cast(float, __builtin_amdgcn_update_dpp(0, __builtin_bit_cast(int, v), 0x141, 0xf, 0xf, true));
    v += __builtin_bit_cast(float, __builtin_amdgcn_update_dpp(0, __builtin_bit_cast(int, v), 0x140, 0xf, 0xf, true));
    v += __shfl_xor(v, 16); v += __shfl_xor(v, 32);
    return v;
}
__device__ __forceinline__ float half_sum(float v) {
    v += __builtin_bit_cast(float, __builtin_amdgcn_update_dpp(0, __builtin_bit_cast(int, v), 0xB1, 0xf, 0xf, true));
    v += __builtin_bit_cast(float, __builtin_amdgcn_update_dpp(0, __builtin_bit_cast(int, v), 0x4E, 0xf, 0xf, true));
    v += __builtin_bit_cast(float, __builtin_amdgcn_update_dpp(0, __builtin_bit_cast(int, v), 0x141, 0xf, 0xf, true));
    v += __builtin_bit_cast(float, __builtin_amdgcn_update_dpp(0, __builtin_bit_cast(int, v), 0x140, 0xf, 0xf, true));
    v += __shfl_xor(v, 16);
    return v;
}
__device__ __forceinline__ void norm1_load(const P& p, int r, int lane, f32x4 (&v)[8]) {
    const float* src = r < T ? p.x + (size_t)r * D : p.ctx + (size_t)(r - T) * D;
#pragma unroll
    for (int j = 0; j < 8; ++j) v[j] = __builtin_nontemporal_load((const f32x4*)(src + 4 * lane + 256 * j));
}
__device__ __forceinline__ void norm1_finish(const P& p, int r, int lane, const f32x4 (&v)[8], const LAS float* GT) {
    float ss = 0.f;
#pragma unroll
    for (int j = 0; j < 8; ++j) ss += (v[j][0] * v[j][0] + v[j][1] * v[j][1]) + (v[j][2] * v[j][2] + v[j][3] * v[j][3]);
    const float rs = rsqrtf(wave_sum(ss) * (1.f / D) + EPS);
    const LAS float* gt = GT + (r < T ? r / SEQ : 4) * 4096;
    bf16* o = (bf16*)(p.ws + WS_XN) + (size_t)r * D;
#pragma unroll
    for (int j = 0; j < 8; ++j) { const int k = 4 * lane + 256 * j; const f32x4 g = *(const LAS f32x4*)(gt + k), sh = *(const LAS f32x4*)(gt + 2048 + k);
        const f32x4 y = (v[j] * rs) * g + sh; u32x2 w; w.x = pk2(y[0], y[1]); w.y = pk2(y[2], y[3]); *(u32x2*)(o + k) = w; }
}
__device__ __forceinline__ void ph_pre(const P& p, const Fr& F) {
    LAS float* scr = (LAS float*)(F.lds + F.wave * 16896);
    constexpr int CV_SMALL = CV_IN + CV_GLU + CV_OUT;
    const int gw = F.bid * NWAVES + F.wave, NGW = F.G * NWAVES;
    LAS float* GT = (LAS float*)F.lds;
    { const f32x4 g = *(const f32x4*)(p.norm1_g + 4 * F.tid); f32x4 sc[5], sh[5];
#pragma unroll
      for (int j = 0; j < 5; ++j) { const float* mod = (const float*)(p.ws + WS_MOD) + j * 12288; sc[j] = *(const f32x4*)(mod + 2048 + 4 * F.tid); sh[j] = *(const f32x4*)(mod + 4 * F.tid); }
#pragma unroll
      for (int j = 0; j < 5; ++j) { *(LAS f32x4*)(GT + j * 4096 + 4 * F.tid) = g * (1.f + sc[j]); *(LAS f32x4*)(GT + j * 4096 + 2048 + 4 * F.tid) = sh[j]; } }
    __syncthreads();
    { int r = gw; f32x4 v[8], vn[8];
      if (r < TR) norm1_load(p, r, F.lane, v);
      while (r < TR) { const int rn = r + NGW; if (rn < TR) norm1_load(p, rn, F.lane, vn);
          norm1_finish(p, r, F.lane, v, GT);
#pragma unroll
          for (int j = 0; j < 8; ++j) v[j] = vn[j];
          r = rn; } }
    __syncthreads();
    for (int i = gw * 64 + F.lane; i < NE * D; i += NGW * 64) { const int e = i >> 11, k = i & 2047; const float w = p.router_w[(size_t)k * NE + e]; const unsigned h = f2bf(w);
        const int fi = (((((k >> 8) * 8 + ((k >> 5) & 7)) * 2 + (e >> 5)) * 2 + ((k >> 3) & 1)) * 64 + ((k >> 4) & 1) * 32 + (e & 31)) * 8 + (k & 7);
        ((bf16*)(p.ws + WS_WRT_HI))[fi] = (bf16)h; ((bf16*)(p.ws + WS_WRT_LO))[fi] = (bf16)f2bf(w - __builtin_bit_cast(float, h << 16)); }
    { float ra[32], rb[32]; int it = gw;
      if (it < CV_SMALL) { CvItem ca = cv_decode(p, it); cv_load(ca, ra, F.lane);
        for (;;) { const int itb = it + NGW; CvItem cb; const bool hb = itb < CV_SMALL; if (hb) { cb = cv_decode(p, itb); cv_load(cb, rb, F.lane); }
            cv_finish(ca, ra, scr, F.lane); if (!hb) break;
            const int itc = itb + NGW; const bool hc = itc < CV_SMALL; if (hc) { ca = cv_decode(p, itc); cv_load(ca, ra, F.lane); }
            cv_finish(cb, rb, scr, F.lane); if (!hc) break; it = itc; } } }
}

__device__ __forceinline__ void conv_slice(const P& p, const Fr& F, int set, int first, int hi, int st) {
    LAS float* scr = (LAS float*)(F.lds + F.wave * 16896);
    __syncthreads();
    { int j = first + F.wave; f32x4 ra[16], rb[16];
      if (j < hi) { CvBig ca = cvb_decode(p, set, j, F.lane); cvb_load(ca, ra);
        for (;;) { CvBig cb; const bool hb = j + st < hi; if (hb) { cb = cvb_decode(p, set, j + st, F.lane); cvb_load(cb, rb); }
            cvb_finish(ca, ra, scr, F.lane); if (!hb) break;
            const bool hc = j + 2 * st < hi; if (hc) { ca = cvb_decode(p, set, j + 2 * st, F.lane); cvb_load(ca, ra); }
            cvb_finish(cb, rb, scr, F.lane); if (!hc) break; j += 2 * st; } } }
    __syncthreads();
}
__device__ __forceinline__ int wave_excl_scan(int v, int lane) {
    int s = v;
#pragma unroll
    for (int o = 1; o < 64; o <<= 1) { const int t = __shfl_up(s, o); if (lane >= o) s += t; }
    return s - v;
}
__device__ __forceinline__ void moe_tables(const P& p, const Fr& F, const int ppc = 1) {
    if (F.wave == 0) { const int e = F.lane; const unsigned* cnt = (const unsigned*)p.ws + CW_CNT;
        const unsigned ce = xb_ld((unsigned*)cnt + e); const int tl = (int)((ce + 255u) >> 8); const int up = wave_excl_scan(tl, e); const int tot = __shfl(up + tl, 63);
        F.misc[MW_TILES + e] = (unsigned)tl; F.misc[MW_UPRE + e] = (unsigned)up; F.misc[MW_SEG + e] = (unsigned)(T + up * 256);
        const int npn = 4 * ppc, total = (tot + 32) * npn, tgt = (total + F.G - 1) / F.G; const int r = tl * ppc, cap = tgt > r ? tgt - r : 0; const int sb = wave_excl_scan(4 * cap, e);
        F.misc[MW_CAP + e] = ce; F.misc[MW_SBASE + e] = (unsigned)sb;
        if (e == 63) { F.misc[MW_TILES + 64] = 32u; F.misc[MW_UPRE + 64] = (unsigned)tot; F.misc[MW_SEG + 64] = 0u; F.misc[MW_UPRE + 65] = (unsigned)(tot + 32); F.misc[MW_SBASE + 64] = (unsigned)(sb + 4 * cap); F.misc[MW_CAP + 64] = (unsigned)T; } }
    __syncthreads();
}


__device__ __forceinline__ void ph_mod(const P& p, const Fr& F) {
    LAS float* sv = (LAS float*)F.lds;
    LAS float* red = (LAS float*)(F.lds + 43008);
    float* mod = (float*)(p.ws + WS_MOD);
    const int vcu = (F.G % 8 == 0) ? (F.bid & 7) * (F.G / 8) + (F.bid >> 3) : F.bid;
    const int cq = F.lane % 12, kr = F.lane / 12; const bool act = kr < 5;
    bool first = true;
    f32x4 cv[5];
#pragma unroll
    for (int j = 0; j < 5; ++j) cv[j] = *(const f32x4*)((j < 4 ? p.c + j * 2048 : p.c_ctx) + 4 * F.tid);
    for (int chunk = vcu; chunk < 256; chunk += F.G) {
        const float* wp = p.w_ada + (size_t)chunk * 48 + cq * 4;
        f32x4 wa[26];
        if (act) {
            { unsigned wo = (unsigned)((chunk * 48 + cq * 4 + (F.wave * 5 + kr) * 12288) * 4);
#pragma unroll
              for (int u = 0; u < 26; ++u) { wa[u] = __builtin_nontemporal_load((const f32x4*)((const char*)p.w_ada + wo)); wo += 40u * 12288u * 4u; asm volatile("" : "+v"(wo)); } } }
        if (first) { first = false;
#pragma unroll
            for (int j = 0; j < 5; ++j) { f32x4 o; o[0] = siluf(cv[j][0]); o[1] = siluf(cv[j][1]); o[2] = siluf(cv[j][2]); o[3] = siluf(cv[j][3]); *(LAS f32x4*)(sv + j * 2080 + 4 * F.tid) = o; }
            if (F.tid < 160) sv[(F.tid >> 5) * 2080 + 2048 + (F.tid & 31)] = 0.f;
            if (F.bid == 0 && F.tid < 64) ((unsigned*)p.ws)[CW_CNT + F.tid] = 0u;
            { u32x4* rz = (u32x4*)(p.ws + WS_ROWS); for (int i = F.bid * 512 + F.tid; i < 64 * 8192 / 4; i += F.G * 512) rz[i] = (u32x4){0u, 0u, 0u, 0u}; }
            __syncthreads(); }
        f32x4 acc[5];
#pragma unroll
        for (int r = 0; r < 5; ++r) acc[r] = (f32x4){0.f, 0.f, 0.f, 0.f};
        if (act) {
#pragma unroll
            for (int u = 0; u < 26; ++u) { const int k = u * 40 + F.wave * 5 + kr;
#pragma unroll
                for (int r = 0; r < 5; ++r) acc[r] += sv[r * 2080 + k] * wa[u]; }
            asm volatile("" ::: "memory");
#pragma unroll 1
            for (int it0 = 26; it0 < 52; it0 += 13) { f32x4 wv[13];
#pragma unroll
                for (int u = 0; u < 13; ++u) { int k = (it0 + u) * 40 + F.wave * 5 + kr; k = k < 2048 ? k : 2047; wv[u] = __builtin_nontemporal_load((const f32x4*)(wp + (size_t)k * 12288)); }
#pragma unroll
                for (int u = 0; u < 13; ++u) { const int k = (it0 + u) * 40 + F.wave * 5 + kr;
#pragma unroll
                    for (int r = 0; r < 5; ++r) acc[r] += sv[r * 2080 + k] * wv[u]; } }
#pragma unroll
            for (int r = 0; r < 5; ++r) *(LAS f32x4*)(red + ((F.wave * 5 + kr) * 5 + r) * 48 + cq * 4) = acc[r];
        }
        __syncthreads();
        if (F.tid < 240) { const int r = F.tid / 48, c = F.tid % 48; float s = p.b_ada[chunk * 48 + c];
            for (int g = 0; g < 40; ++g) s += red[(g * 5 + r) * 48 + c];
            mod[r * 12288 + chunk * 48 + c] = s; }
        __syncthreads();
    }
}
__device__ __forceinline__ float bflo(unsigned w) { return __builtin_bit_cast(float, w << 16); }
__device__ __forceinline__ float bfhi(unsigned w) { return __builtin_bit_cast(float, w & 0xffff0000u); }
struct CRow { u32x4 zc[2], zl[2], zr[2], bg[2]; };
__device__ __forceinline__ void conv_load(const P& p, int m, int lane, CRow& R) {
    const bf16* Z = (const bf16*)(p.ws + WS_Z); const bf16* BG = (const bf16*)(p.ws + WS_BG); const int i = m & 63;
#pragma unroll
    for (int j = 0; j < 2; ++j) { const int ch = 8 * lane + 512 * j;
        R.zc[j] = *(const u32x4*)(Z + (size_t)m * DS + ch); R.zl[j] = i > 0 ? *(const u32x4*)(Z + (size_t)(m - 1) * DS + ch) : (u32x4){0u, 0u, 0u, 0u}; R.zr[j] = i < 63 ? *(const u32x4*)(Z + (size_t)(m + 1) * DS + ch) : (u32x4){0u, 0u, 0u, 0u};
        R.bg[j] = *(const u32x4*)(BG + (size_t)m * DS + ch); }
}
__device__ __forceinline__ void conv_finish(const P& p, int m, int lane, const CRow& R, const LAS float* CT) {
    float cy[2][8]; float ss = 0.f;
#pragma unroll
    for (int j = 0; j < 2; ++j) { const int ch = 8 * lane + 512 * j; const u32x4 zc = R.zc[j], zl = R.zl[j], zr = R.zr[j], bg = R.bg[j];
        const f32x4 cb0 = *(const LAS f32x4*)(CT + ch), cb1 = *(const LAS f32x4*)(CT + ch + 4), w00 = *(const LAS f32x4*)(CT + 1024 + ch), w01 = *(const LAS f32x4*)(CT + 1024 + ch + 4),
                    w10 = *(const LAS f32x4*)(CT + 2048 + ch), w11 = *(const LAS f32x4*)(CT + 2048 + ch + 4), w20 = *(const LAS f32x4*)(CT + 3072 + ch), w21 = *(const LAS f32x4*)(CT + 3072 + ch + 4);
#pragma unroll
        for (int e = 0; e < 8; ++e) { const float l_ = (e & 1) ? bfhi(zl[e >> 1]) : bflo(zl[e >> 1]), c_ = (e & 1) ? bfhi(zc[e >> 1]) : bflo(zc[e >> 1]), r_ = (e & 1) ? bfhi(zr[e >> 1]) : bflo(zr[e >> 1]);
            const float bgv = (e & 1) ? bfhi(bg[e >> 1]) : bflo(bg[e >> 1]);
            const float cb = e < 4 ? cb0[e & 3] : cb1[e & 3], w0 = e < 4 ? w00[e & 3] : w01[e & 3], w1 = e < 4 ? w10[e & 3] : w11[e & 3], w2 = e < 4 ? w20[e & 3] : w21[e & 3];
            const float y = cb + w0 * l_ + w1 * c_ + w2 * r_; cy[j][e] = bgv * y; ss += cy[j][e] * cy[j][e]; } }
    const float rs = rsqrtf(wave_sum(ss) * (1.f / DS) + EPS);
#pragma unroll
    for (int j = 0; j < 2; ++j) { const int ch = 8 * lane + 512 * j; const f32x4 g0 = *(const LAS f32x4*)(CT + 4096 + ch), g1 = *(const LAS f32x4*)(CT + 4096 + ch + 4); u32x4 o;
#pragma unroll
        for (int e = 0; e < 4; ++e) { const float ga = e < 2 ? g0[2 * e] : g1[2 * e - 4], gb = e < 2 ? g0[2 * e + 1] : g1[2 * e - 3]; o[e] = pk2(cy[j][2 * e] * rs * ga, cy[j][2 * e + 1] * rs * gb); }
        *(u32x4*)((bf16*)(p.ws + WS_HEADS) + (size_t)m * D + DS + ch) = o; }
}
constexpr int SS_R1 = 0, SS_M1S = 528, SS_HS = 272, SS_T2 = 39168, SS_R2 = 69632, SS_R3 = 144384, SS_B2T = 153088;
static_assert(SS_R3 + 17 * 512 == SS_B2T && SS_B2T + 16 * SS_HS <= MISC_OFF, "ssm lds map");
typedef float f32x2 __attribute__((ext_vector_type(2)));
__device__ __forceinline__ f32x2 cmul(f32x2 a, f32x2 b) { return (f32x2){a.x * b.x - a.y * b.y, a.x * b.y + a.y * b.x}; }
__device__ __forceinline__ f32x2 lam_pow(float lre, float lim, float dt, int e) { const float m = __expf((float)e * dt * lre), ang = (float)e * dt * lim; const float kq = rintf(ang * 0.15915494309189535f); float rr = fmaf(-kq, 6.28318548202514648f, ang); rr = fmaf(-kq, -1.7484556000744883e-07f, rr); const float s = __sinf(rr), c = __cosf(rr); return (f32x2){m * c, m * s}; }
__device__ __forceinline__ void ssm_item(const P& p, const Fr& F, int item) {
    const int b = item & 3, g = item >> 2, tid = F.tid, lane = F.lane, w = F.wave, fr = lane & 15, q = lane >> 4;
    LAS unsigned char* lds = F.lds;
    const bf16* U = (const bf16*)(p.ws + WS_U);
    bf16x8v ufr[8];
    { const bf16* ub = U + (size_t)(b * SEQ + (16 * w + fr) * 16 + (q >> 1)) * DS + g * 16 + 8 * (q & 1);
#pragma unroll
      for (int ks = 0; ks < 8; ++ks) ufr[ks] = *(const bf16x8v*)(ub + (size_t)(2 * ks) * DS); }
    float pl0r[2], pl0i[2], plbr0[2], plbi0[2], plbr1[2], plbi1[2], pldt[2]; f32x2 pb0v[2], pb1v[2], pc0[2], pc1[2];
#pragma unroll
    for (int d = 0; d < 2; ++d) { const int gd = d * 64 + g, p0 = tid & 63, pb0 = tid >> 4, pb1 = pb0 + 32, n = tid & 15;
        pldt[d] = p.log_dt[gd]; pl0r[d] = p.lam_re[gd * 64 + p0]; pl0i[d] = p.lam_im[gd * 64 + p0];
        plbr0[d] = p.lam_re[gd * 64 + pb0]; plbi0[d] = p.lam_im[gd * 64 + pb0]; plbr1[d] = p.lam_re[gd * 64 + pb1]; plbi1[d] = p.lam_im[gd * 64 + pb1];
        pb0v[d] = (f32x2){p.b_re[(size_t)(gd * 64 + pb0) * 16 + n], p.b_im[(size_t)(gd * 64 + pb0) * 16 + n]}; pb1v[d] = (f32x2){p.b_re[(size_t)(gd * 64 + pb1) * 16 + n], p.b_im[(size_t)(gd * 64 + pb1) * 16 + n]};
        pc0[d] = (f32x2){p.c_re[(size_t)gd * 1024 + tid], p.c_im[(size_t)gd * 1024 + tid]}; pc1[d] = (f32x2){p.c_re[(size_t)gd * 1024 + 512 + tid], p.c_im[(size_t)gd * 1024 + 512 + tid]}; }
    const float dskip = p.ssm_d[g * 16 + fr];
    f32x4 acc[16];
#pragma unroll 1
    for (int d = 0; d < 2; ++d) {
        const float l0r = d ? pl0r[1] : pl0r[0], l0i = d ? pl0i[1] : pl0i[0], lbr0 = d ? plbr0[1] : plbr0[0], lbi0 = d ? plbi0[1] : plbi0[0], lbr1 = d ? plbr1[1] : plbr1[0], lbi1 = d ? plbi1[1] : plbi1[0];
        const f32x2 b0 = d ? pb0v[1] : pb0v[0], b1 = d ? pb1v[1] : pb1v[0], cc0 = d ? pc0[1] : pc0[0], cc1 = d ? pc1[1] : pc1[0];
        int fr_ = fr, q_ = q; asm volatile("" : "+v"(fr_), "+v"(q_));
        const float dt = __expf(d ? pldt[1] : pldt[0]);
        bf16x8v cfr[8];
        { const bf16* cb = U + (size_t)(T + b * CTXL + fr_ * 16 + (q_ >> 1)) * DS + g * 16 + 8 * (q_ & 1);
#pragma unroll
          for (int ks = 0; ks < 8; ++ks) cfr[ks] = *(const bf16x8v*)(cb + (size_t)(2 * ks) * DS); }
        LAS f32x2* Ltab = (LAS f32x2*)(lds + SS_R3); LAS f32x2* Btab = (LAS f32x2*)(lds + SS_R2 + 8704); LAS unsigned char* B2T = lds + SS_B2T;
        { const int p0 = tid & 63, pb0 = tid >> 4, pb1 = pb0 + 32, n = tid & 15;
          for (int idx = tid; idx < 17 * 64; idx += 512) Ltab[idx] = lam_pow(l0r, l0i, dt, idx >> 6);
          { const f32x2 lb = lam_pow(lbr0, lbi0, dt, 1); const float nr = lb.x - 1.f, ni = lb.y, den = lbr0 * lbr0 + lbi0 * lbi0; const f32x2 v = cmul((f32x2){(nr * lbr0 + ni * lbi0) / den, (ni * lbr0 - nr * lbi0) / den}, b0); Btab[tid] = v;
            const unsigned vw = pk2(v.x, v.y); *(LAS bf16*)(B2T + n * SS_HS + pb0 * 2) = (bf16)(vw & 0xffffu); *(LAS bf16*)(B2T + n * SS_HS + (64 + pb0) * 2) = (bf16)(vw >> 16); }
          { const f32x2 lb = lam_pow(lbr1, lbi1, dt, 1); const float nr = lb.x - 1.f, ni = lb.y, den = lbr1 * lbr1 + lbi1 * lbi1; const f32x2 v = cmul((f32x2){(nr * lbr1 + ni * lbi1) / den, (ni * lbr1 - nr * lbi1) / den}, b1); Btab[tid + 512] = v;
            const unsigned vw = pk2(v.x, v.y); *(LAS bf16*)(B2T + n * SS_HS + pb1 * 2) = (bf16)(vw & 0xffffu); *(LAS bf16*)(B2T + n * SS_HS + (64 + pb1) * 2) = (bf16)(vw >> 16); } }
        __syncthreads();
        const f32x2 A16 = Ltab[16 * 64 + lane];
        for (int idx = tid; idx < 1024; idx += 512) { const int pp = idx & 63, j = idx >> 6, e = d == 0 ? 15 - j : j; const f32x2 wv = Ltab[e * 64 + pp];
            u32x4 re0, re1, im0, im1;
#pragma unroll
            for (int n2 = 0; n2 < 8; ++n2) { const f32x2 v0 = cmul(wv, Btab[pp * 16 + 2 * n2]), v1 = cmul(wv, Btab[pp * 16 + 2 * n2 + 1]);
                const unsigned r = pk2(v0.x, v1.x), im = pk2(v0.y, v1.y); if (n2 < 4) { re0[n2] = r; im0[n2] = im; } else { re1[n2 - 4] = r; im1[n2 - 4] = im; } }
            LAS unsigned char* r0 = lds + SS_R1 + pp * SS_M1S + j * 32; LAS unsigned char* r1 = lds + SS_R1 + (64 + pp) * SS_M1S + j * 32;
            *(LAS u32x4*)r0 = re0; *(LAS u32x4*)(r0 + 16) = re1; *(LAS u32x4*)r1 = im0; *(LAS u32x4*)(r1 + 16) = im1; }
        __syncthreads();
        { LAS float* S = (LAS float*)(lds + SS_R2);
#pragma unroll 2
          for (int rt = 0; rt < 8; ++rt) { f32x4 sa = (f32x4){0.f, 0.f, 0.f, 0.f};
#pragma unroll
              for (int ks = 0; ks < 8; ++ks) { const bf16x8v af = *(const LAS bf16x8v*)(lds + SS_R1 + (rt * 16 + fr_) * SS_M1S + (ks * 32 + 8 * q_) * 2); sa = __builtin_amdgcn_mfma_f32_16x16x32_bf16(af, ufr[ks], sa, 0, 0, 0); }
              *(LAS f32x4*)(S + (16 * w + fr_) * 128 + rt * 16 + 4 * q_) = sa; }
          { f32x4 sc_ = (f32x4){0.f, 0.f, 0.f, 0.f};
#pragma unroll
            for (int ks = 0; ks < 8; ++ks) { const bf16x8v cf = cfr[ks]; const bf16x8v af = *(const LAS bf16x8v*)(lds + SS_R1 + (w * 16 + fr_) * SS_M1S + (ks * 32 + 8 * q_) * 2);
                sc_ = __builtin_amdgcn_mfma_f32_16x16x32_bf16(af, cf, sc_, 0, 0, 0); }
            *(LAS f32x4*)(S + (128 + fr_) * 128 + w * 16 + 4 * q_) = sc_; } }
        __syncthreads();
        { const LAS float* S = (const LAS float*)(lds + SS_R2); LAS float* Tg = (LAS float*)(lds + SS_R1 + SS_T2 + 16896);
          float hr = 0.f, hi = 0.f;
#pragma unroll 4
          for (int s = 0; s < 16; ++s) { const int c = 128 + (d == 0 ? s : 15 - s); const float sr_ = S[c * 128 + lane], si_ = S[c * 128 + 64 + lane];
              const float nr = A16.x * hr - A16.y * hi + sr_, ni = A16.x * hi + A16.y * hr + si_; hr = nr; hi = ni; }
          float tr = 0.f, ti = 0.f;
#pragma unroll 4
          for (int s = 0; s < 16; ++s) { const int c = 16 * w + (d == 0 ? s : 15 - s); const float sr_ = S[c * 128 + lane], si_ = S[c * 128 + 64 + lane];
              const float nr = A16.x * tr - A16.y * ti + sr_, ni = A16.x * ti + A16.y * tr + si_; tr = nr; ti = ni; }
          Tg[w * 128 + lane] = tr; Tg[w * 128 + 64 + lane] = ti;
          f32x2 A256 = A16;
#pragma unroll
          for (int s = 0; s < 4; ++s) A256 = cmul(A256, A256);
          { LAS f32x2* C2 = (LAS f32x2*)(lds + SS_R1 + SS_T2 + 8704); C2[tid] = cc0; C2[tid + 512] = cc1; }
          __syncthreads();
          const int nprev = d == 0 ? w : 7 - w;
          for (int s = 0; s < nprev; ++s) { const int sg = d == 0 ? s : 7 - s; const float t0_ = Tg[sg * 128 + lane], t1_ = Tg[sg * 128 + 64 + lane];
              const float nr = A256.x * hr - A256.y * hi + t0_, ni = A256.x * hi + A256.y * hr + t1_; hr = nr; hi = ni; }
#pragma unroll 4
          for (int s = 0; s < 16; ++s) { const int c = 16 * w + (d == 0 ? s : 15 - s); const float sr_ = S[c * 128 + lane], si_ = S[c * 128 + 64 + lane];
              { const unsigned hw = pk2(hr, hi); *(LAS bf16*)(lds + SS_R1 + c * SS_HS + lane * 2) = (bf16)(hw & 0xffffu); *(LAS bf16*)(lds + SS_R1 + c * SS_HS + (64 + lane) * 2) = (bf16)(hw >> 16); }
              const float nr = A16.x * hr - A16.y * hi + sr_, ni = A16.x * hi + A16.y * hr + si_; hr = nr; hi = ni; } }
        __syncthreads();
        { const LAS f32x2* L2 = (const LAS f32x2*)(lds + SS_R3); const LAS f32x2* C2 = (const LAS f32x2*)(lds + SS_R1 + SS_T2 + 8704);
          const int l2 = 2 * (tid & 31), n = tid >> 5; const f32x4 cq = *(const LAS f32x4*)(C2 + n * 64 + l2);
          const f32x2 ca = {cq[0], cq[1]}, cb2 = {cq[2], cq[3]};
#pragma unroll
          for (int tau = 0; tau < 17; ++tau) { const f32x4 wq = *(const LAS f32x4*)(L2 + tau * 64 + l2); const f32x2 v0 = cmul(ca, (f32x2){wq[0], wq[1]}), v1 = cmul(cb2, (f32x2){wq[2], wq[3]});
              LAS unsigned char* rp = lds + SS_R2 + (tau * 16 + n) * SS_HS; *(LAS unsigned*)(rp + l2 * 2) = pk2(v0.x, v1.x); *(LAS unsigned*)(rp + 128 + l2 * 2) = pk2(-v0.y, -v1.y); } }
        __syncthreads();
        { const LAS unsigned char* B2T = lds + SS_B2T; bf16x8v bfg[4];
#pragma unroll
          for (int ks = 0; ks < 4; ++ks) bfg[ks] = *(const LAS bf16x8v*)(B2T + fr_ * SS_HS + (ks * 32 + 8 * q_) * 2);
#pragma unroll
          for (int t2 = 0; t2 < 2; ++t2) { const int tau = 2 * w + t2; f32x4 ka = (f32x4){0.f, 0.f, 0.f, 0.f};
#pragma unroll
              for (int ks = 0; ks < 4; ++ks) { const bf16x8v af = *(const LAS bf16x8v*)(lds + SS_R2 + (tau * 16 + fr_) * SS_HS + (ks * 32 + 8 * q_) * 2); ka = __builtin_amdgcn_mfma_f32_16x16x32_bf16(af, bfg[ks], ka, 0, 0, 0); }
              if (d == 0 && tau == 0) {
#pragma unroll
                  for (int r = 0; r < 4; ++r) ka[r] += (4 * q_ + r == fr_) ? dskip : 0.f; }
#pragma unroll
              for (int r = 0; r < 4; ++r) *(LAS bf16*)(lds + SS_R3 + ((tau * 16 + 4 * q_ + r) * 16 + fr_) * 2) = (bf16)f2bf(ka[r]); }
          if (tid < 32) *(LAS u32x4*)(lds + SS_R3 + 16 * 512 + tid * 16) = (u32x4){0u, 0u, 0u, 0u}; }
        __syncthreads();
        { bf16x8v hfr[4];
#pragma unroll
          for (int ks = 0; ks < 4; ++ks) hfr[ks] = *(const LAS bf16x8v*)(lds + SS_R1 + (16 * w + fr_) * SS_HS + (ks * 32 + 8 * q_) * 2);
#define SSM_F(DD) do { _Pragma("unroll") for (int i = 0; i < 16; ++i) { \
              _Pragma("unroll") for (int ks = 0; ks < 4; ++ks) { const bf16x8v af = *(const LAS bf16x8v*)(lds + SS_R2 + (((DD) == 0 ? i + 1 : 16 - i) * 16 + fr_) * SS_HS + (ks * 32 + 8 * q_) * 2); acc[i] = __builtin_amdgcn_mfma_f32_16x16x32_bf16(af, hfr[ks], ((DD) == 0 && ks == 0) ? (f32x4){0.f, 0.f, 0.f, 0.f} : acc[i], 0, 0, 0); } \
              _Pragma("unroll") for (int ks = 0; ks < 8; ++ks) { if ((DD) == 0 ? (2 * ks <= i) : (2 * ks + 1 >= i)) { const int j = 2 * ks + (q_ >> 1); const bool ok = (DD) == 0 ? (j <= i) : (j >= i); const int tau = ok ? (j > i ? j - i : i - j) : 16; \
                      const bf16x8v af = *(const LAS bf16x8v*)(lds + SS_R3 + ((tau * 16 + fr_) * 16 + 8 * (q_ & 1)) * 2); acc[i] = __builtin_amdgcn_mfma_f32_16x16x32_bf16(af, ufr[ks], acc[i], 0, 0, 0); } } \
              if (i & 1) __builtin_amdgcn_sched_barrier(0); } } while (0)
          if (d == 0) SSM_F(0); else SSM_F(1);
#undef SSM_F
        }
        __syncthreads();
    }
    { const int ch0 = g * 16 + 4 * q; bf16* GY = (bf16*)(p.ws + WS_GY);
#pragma unroll
      for (int i = 0; i < 16; ++i) { const size_t off = (size_t)(b * SEQ + (16 * w + fr) * 16 + i) * DS + ch0;
          u32x2 o; o.x = pk2(gelu_fast(acc[i][0]), gelu_fast(acc[i][1])); o.y = pk2(gelu_fast(acc[i][2]), gelu_fast(acc[i][3])); *(u32x2*)(GY + off) = o; } }
}
__device__ __forceinline__ void ph_ssm(const P& p, const Fr& F) {
    for (int item = F.bid; item < 256; item += F.G) ssm_item(p, F, item);
    const int gw = F.bid * NWAVES + F.wave, NGW = F.G * NWAVES;
    LAS float* CT = (LAS float*)F.lds;
    { f32x4 tv[3];
#pragma unroll
      for (int u = 0; u < 3; ++u) { const int i = F.tid + 512 * u, tb = i >> 8, k4 = (i & 255) * 4; const float* src = tb == 0 ? p.conv_b : tb < 4 ? p.conv_w + (tb - 1) * DS : p.mix_g + DS; if (i < 5 * 256) tv[u] = *(const f32x4*)(src + k4); }
#pragma unroll
      for (int u = 0; u < 3; ++u) { const int i = F.tid + 512 * u, tb = i >> 8, k4 = (i & 255) * 4; if (i < 5 * 256) *(LAS f32x4*)(CT + tb * 1024 + k4) = tv[u]; } }
    __syncthreads();
    { int m = gw; CRow R, Rn; if (m < T) conv_load(p, m, F.lane, R);
      while (m < T) { const int mn = m + NGW; if (mn < T) conv_load(p, mn, F.lane, Rn);
          conv_finish(p, m, F.lane, R, CT); R = Rn; m = mn; } }
}
typedef float f32x16 __attribute__((ext_vector_type(16)));
constexpr int RT_STG = 16640;
__device__ __forceinline__ void ph_route(const P& p, const Fr& F) {
    LAS float* Gv = (LAS float*)F.lds; LAS float* Sh = Gv + 2048; LAS float* RS = Gv + 4096;
    LAS float* LG = (LAS float*)F.lds;
    LAS float* GS = (LAS float*)(F.lds + 8192);
    LAS unsigned* rec = (LAS unsigned*)(F.lds + 9216);
    LAS float* rwt = (LAS float*)(F.lds + 10240);
    LAS unsigned* lcnt = (LAS unsigned*)(F.lds + RT_STG + 131072);
    const bf16* x1 = (const bf16*)(p.ws + WS_X1B); unsigned char* XN8 = p.ws + WS_XN8; const float* rsx = (const float*)(p.ws + WS_RSP_X1);
    const bf16* WH = (const bf16*)(p.ws + WS_WRT_HI); const bf16* WL = (const bf16*)(p.ws + WS_WRT_LO);
    for (int grp = F.bid; grp < T / 32; grp += F.G) {
        const int t0 = grp * 32, b = t0 / SEQ; const float* mod = (const float*)(p.ws + WS_MOD) + b * 12288;
        const int r = F.lane & 31, h = F.lane >> 5;
        LAS unsigned char* stg = F.lds + RT_STG + F.wave * 16384;
        unsigned wo = (unsigned)((F.wave * 2048 + F.lane) * 16);
        unsigned xo = (unsigned)(((t0 + (F.lane >> 3)) * D + F.wave * 256) * 2);
        const unsigned xsl = (unsigned)(F.lane & 7), xrh = (unsigned)((F.lane >> 3) >> 1);
        asm volatile("" : "+v"(wo), "+v"(xo));
        bf16x8v bh[2][2][2], bl[2][2][2];
#define RT_LDB(buf) do { _Pragma("unroll") for (int j = 0; j < 2; ++j) _Pragma("unroll") for (int s_ = 0; s_ < 2; ++s_) { bh[buf][j][s_] = *(const bf16x8v*)((const char*)WH + wo + (j * 2 + s_) * 1024); bl[buf][j][s_] = *(const bf16x8v*)((const char*)WL + wo + (j * 2 + s_) * 1024); } \
            wo += 4096u; asm volatile("" : "+v"(wo)); } while (0)
#define RT_DMA(q) do { _Pragma("unroll") for (int c = 0; c < 4; ++c) __builtin_amdgcn_global_load_lds((const unsigned*)((const char*)x1 + xo + (unsigned)((8 * c * D + 64 * (q)) * 2) + ((xsl ^ ((unsigned)(4 * (c & 1)) | xrh)) << 4)), (LAS unsigned*)(stg + ((q) & 1) * 4096 + c * 1024), 16, 0, 2); } while (0)
        RT_LDB(0); RT_DMA(0); RT_DMA(1);
        { const int k = 4 * F.tid; const f32x4 g = *(const f32x4*)(p.norm2_g + k), sc = *(const f32x4*)(mod + 4 * 2048 + k), sh = *(const f32x4*)(mod + 3 * 2048 + k);
          *(LAS f32x4*)(Gv + k) = g * (1.f + sc); *(LAS f32x4*)(Sh + k) = sh; }
        if (F.tid < 64) lcnt[F.tid] = 0u;
        { float a0 = rsx[(t0 + 4 * F.wave + h) * 32 + r], a1 = rsx[(t0 + 4 * F.wave + 2 + h) * 32 + r];
          a0 = half_sum(a0); a1 = half_sum(a1);
          if (r == 0) { RS[4 * F.wave + h] = rsqrtf(a0 * (1.f / D) + EPS); RS[4 * F.wave + 2 + h] = rsqrtf(a1 * (1.f / D) + EPS); } }
        __syncthreads();
        { const float rs = RS[r]; const int kk0 = F.wave * 256 + 16 * h;
          unsigned oo = (unsigned)((t0 + r) * D + kk0); asm volatile("" : "+v"(oo));
          const LAS unsigned char* xl = stg + (r >> 3) * 1024 + (r & 7) * 128; const unsigned fh = (unsigned)(((r >> 1) & 7) ^ (2 * h));
          f32x16 c1[2], c2[2];
#pragma unroll
          for (int j = 0; j < 2; ++j)
#pragma unroll
              for (int v = 0; v < 16; ++v) { c1[j][v] = 0.f; c2[j][v] = 0.f; }
          asm volatile("s_waitcnt vmcnt(4)" ::: "memory");
#pragma unroll
          for (int t = 0; t < 8; ++t) {
              if (t + 1 < 8) RT_LDB((t + 1) & 1);
              f32x4 y[4];
              u32x4 xw[2];
#pragma unroll
              for (int pc = 0; pc < 2; ++pc) xw[pc] = *(const LAS u32x4*)(xl + ((t >> 1) & 1) * 4096 + ((((unsigned)(4 * (t & 1) + pc)) ^ fh) << 4));
#pragma unroll
              for (int i = 0; i < 4; ++i) { const unsigned w0 = xw[i >> 1][2 * (i & 1)], w1 = xw[i >> 1][2 * (i & 1) + 1]; const f32x4 xv = {bflo(w0), bfhi(w0), bflo(w1), bfhi(w1)};
                  const f32x4 gq = *(const LAS f32x4*)(Gv + kk0 + 32 * t + 4 * i), sq = *(const LAS f32x4*)(Sh + kk0 + 32 * t + 4 * i); y[i] = (xv * rs) * gq + sq; }
              u32x4 o8;
#pragma unroll
              for (int i = 0; i < 4; ++i) o8[i] = pk4_fp8(16.f * y[i][0], 16.f * y[i][1], 16.f * y[i][2], 16.f * y[i][3]);
              *(u32x4*)(XN8 + oo + 32 * t) = o8;
              bf16x8v ah[2], al[2];
#pragma unroll
              for (int s_ = 0; s_ < 2; ++s_) { u32x4 wh_, wl_;
#pragma unroll
                  for (int i2 = 0; i2 < 4; ++i2) { const float v0 = y[2 * s_ + (i2 >> 1)][2 * (i2 & 1)], v1 = y[2 * s_ + (i2 >> 1)][2 * (i2 & 1) + 1]; const unsigned hw = pg8::cvt_pk_bf16(v0, v1);
                      wh_[i2] = hw; wl_[i2] = pg8::cvt_pk_bf16(v0 - __builtin_bit_cast(float, hw << 16), v1 - __builtin_bit_cast(float, hw & 0xffff0000u)); }
                  ah[s_] = __builtin_bit_cast(bf16x8v, wh_); al[s_] = __builtin_bit_cast(bf16x8v, wl_); }
#pragma unroll
              for (int s_ = 0; s_ < 2; ++s_) {
                  c1[0] = __builtin_amdgcn_mfma_f32_32x32x16_bf16(ah[s_], bh[t & 1][0][s_], c1[0], 0, 0, 0); c1[1] = __builtin_amdgcn_mfma_f32_32x32x16_bf16(ah[s_], bh[t & 1][1][s_], c1[1], 0, 0, 0);
                  c2[0] = __builtin_amdgcn_mfma_f32_32x32x16_bf16(ah[s_], bl[t & 1][0][s_], c2[0], 0, 0, 0); c2[1] = __builtin_amdgcn_mfma_f32_32x32x16_bf16(ah[s_], bl[t & 1][1][s_], c2[1], 0, 0, 0);
                  c1[0] = __builtin_amdgcn_mfma_f32_32x32x16_bf16(al[s_], bh[t & 1][0][s_], c1[0], 0, 0, 0); c1[1] = __builtin_amdgcn_mfma_f32_32x32x16_bf16(al[s_], bh[t & 1][1][s_], c1[1], 0, 0, 0); }
              if (t & 1) {
                  asm volatile("s_waitcnt lgkmcnt(0)" ::: "memory");
                  if ((t >> 1) + 2 < 4) { RT_DMA((t >> 1) + 2); asm volatile("s_waitcnt vmcnt(4)" ::: "memory"); } else asm volatile("s_waitcnt vmcnt(0)" ::: "memory"); }
              else asm volatile("" ::: "memory");
          }
          LAS float* PLw = (LAS float*)stg;
#pragma unroll
          for (int j = 0; j < 2; ++j)
#pragma unroll
              for (int v = 0; v < 16; ++v) PLw[(8 * (v >> 2) + 4 * h + (v & 3)) * 64 + 32 * j + r] = c1[j][v] + c2[j][v]; }
#undef RT_DMA
#undef RT_LDB
        __syncthreads();
        const float rbias = p.router_b[F.lane];
#pragma unroll 1
        for (int tt = 0; tt < 4; ++tt) { const int ti = F.wave * 4 + tt, e = F.lane; LAS float* row = LG + ti * 64; LAS float* gsa = GS + ti * 8;
            float pl[8];
#pragma unroll
            for (int k8 = 0; k8 < 8; ++k8) pl[k8] = ((const LAS float*)(F.lds + RT_STG + k8 * 16384))[ti * 64 + e];
            float lg = pl[0];
#pragma unroll
            for (int k8 = 1; k8 < 8; ++k8) lg += pl[k8];
            const float sc = sigmf(lg); const float bz = sc + rbias;
            row[e] = bz; asm volatile("s_waitcnt lgkmcnt(0)" ::: "memory");
            { const f32x4 g0 = *(const LAS f32x4*)(row + (e & ~7)), g1 = *(const LAS f32x4*)(row + (e & ~7) + 4); float m1 = -INFINITY, m2 = -INFINITY;
#pragma unroll
              for (int j = 0; j < 8; ++j) { const float x = j < 4 ? g0[j] : g1[j - 4]; const float lo = fminf(m1, x); m1 = fmaxf(m1, x); m2 = fmaxf(m2, lo); }
              if ((e & 7) == 0) gsa[e >> 3] = m1 + m2; }
            asm volatile("s_waitcnt lgkmcnt(0)" ::: "memory");
            int grk = 0; const int g = e >> 3; float gs;
            { const f32x4 s0 = *(const LAS f32x4*)gsa, s1 = *(const LAS f32x4*)(gsa + 4); gs = g < 4 ? s0[g & 3] : s1[g & 3];
#pragma unroll
              for (int j = 0; j < 8; ++j) { const float o = j < 4 ? s0[j] : s1[j - 4]; grk += (int)(o > gs) | ((int)(o == gs) & (int)(j < g)); } }
            const bool gsel = grk < 4; const float bm = gsel ? bz : -INFINITY;
            asm volatile("s_waitcnt lgkmcnt(0)" ::: "memory"); row[e] = bm; asm volatile("s_waitcnt lgkmcnt(0)" ::: "memory");
            int erk = 0;
#pragma unroll
            for (int hf = 0; hf < 2; ++hf) { f32x4 ov[8];
#pragma unroll
              for (int j4 = 0; j4 < 8; ++j4) ov[j4] = *(const LAS f32x4*)(row + 32 * hf + 4 * j4);
#pragma unroll
              for (int j4 = 0; j4 < 8; ++j4)
#pragma unroll
                  for (int t = 0; t < 4; ++t) erk += (int)(ov[j4][t] > bm) | ((int)(ov[j4][t] == bm) & (int)(32 * hf + 4 * j4 + t < e)); }
            const bool sel = gsel && erk < 8;
            const float wsum = wave_sum(sel ? sc : 0.f);
            if (sel) { const unsigned loc = __hip_atomic_fetch_add(&lcnt[e], 1u, __ATOMIC_RELAXED, __HIP_MEMORY_SCOPE_WORKGROUP); rec[ti * 8 + erk] = ((unsigned)e << 16) | loc; rwt[ti * 8 + erk] = sc / wsum * 2.5f; } }
        __syncthreads();
        if (F.tid < 64) { const unsigned n = lcnt[F.tid]; lcnt[64 + F.tid] = n ? atomicAdd((unsigned*)p.ws + CW_CNT + F.tid, n) : 0u; }
        __syncthreads();
        if (F.tid < 256) { const unsigned rv = rec[F.tid], e = rv >> 16, idx = lcnt[64 + e] + (rv & 0xffffu); const int row = t0 + (F.tid >> 3);
            ((int*)(p.ws + WS_ROWS))[e * 8192 + idx] = row; ((unsigned*)(p.ws + WS_POS))[row * 8 + (F.tid & 7)] = (e << 16) | idx; ((float*)(p.ws + WS_WTS))[row * 8 + (F.tid & 7)] = rwt[F.tid]; }
        __syncthreads();
    }
}
__device__ __forceinline__ float wave_sum_dpp(float v) {
    v += __builtin_bit_cast(float, __builtin_amdgcn_update_dpp(0, __builtin_bit_cast(int, v), 0xB1, 0xf, 0xf, true));
    v += __builtin_bit_cast(float, __builtin_amdgcn_update_dpp(0, __builtin_bit_cast(int, v), 0x4E, 0xf, 0xf, true));
    v += __builtin_bit_cast(float, __builtin_amdgcn_update_dpp(0, __builtin_bit_cast(int, v), 0x141, 0xf, 0xf, true));
    v += __builtin_bit_cast(float, __builtin_amdgcn_update_dpp(0, __builtin_bit_cast(int, v), 0x140, 0xf, 0xf, true));
    v += __shfl_xor(v, 16); v += __shfl_xor(v, 32);
    return v;
}
typedef float f32x2_ __attribute__((ext_vector_type(2)));
struct FinBuf { u32x4 y[9]; u32x4 xa, xb; };
__device__ __forceinline__ void fin_acc(float (&a)[16], const u32x4 y, const float w) {
#pragma unroll
    for (int d = 0; d < 4; ++d) { const f32x2_ lo = __builtin_amdgcn_cvt_pk_f32_fp8((int)y[d], false), hi = __builtin_amdgcn_cvt_pk_f32_fp8((int)y[d], true);
        a[4 * d] += w * lo.x; a[4 * d + 1] += w * lo.y; a[4 * d + 2] += w * hi.x; a[4 * d + 3] += w * hi.y; }
}
__device__ __forceinline__ void ph_final(const P& p, const Fr& F) {
    float* dst = p.out;
    const int gw = F.bid * NWAVES + F.wave, NGW = F.G * NWAVES; const unsigned char* YS = p.ws + WS_YS;
    LAS float* xs = (LAS float*)(F.lds + F.wave * 8192);
    LAS float* G2T = (LAS float*)(F.lds + 65536);
    { f32x4 gq[5];
#pragma unroll
      for (int j = 0; j < 4; ++j) gq[j] = *(const f32x4*)((const float*)(p.ws + WS_MOD) + j * 12288 + 5 * 2048 + 4 * F.tid);
      gq[4] = *(const f32x4*)(p.final_g + 4 * F.tid);
#pragma unroll
      for (int j = 0; j < 5; ++j) *(LAS f32x4*)(G2T + j * 2048 + 4 * F.tid) = gq[j]; }
    __syncthreads();
    unsigned pv = 0u; float wv = 0.f; if (gw < T && F.lane < 8) { pv = ((const unsigned*)(p.ws + WS_POS))[gw * 8 + F.lane]; wv = ((const float*)(p.ws + WS_WTS))[gw * 8 + F.lane]; }
    for (int row = gw; row < T; row += NGW) {
        const int b = row / SEQ; const LAS float* g2 = G2T + b * 2048; const bf16* xr = (const bf16*)(p.ws + WS_X1B) + (size_t)row * D;
        unsigned rows[8]; float w[8];
#pragma unroll
        for (int r = 0; r < 8; ++r) { const unsigned pr = (unsigned)__shfl((int)pv, r); w[r] = __shfl(wv, r) * 0.0625f; rows[r] = F.misc[MW_SEG + (pr >> 16)] + (pr & 0xffffu); }
        { const int nrow = row + NGW; pv = 0u; wv = 0.f; if (nrow < T && F.lane < 8) { pv = ((const unsigned*)(p.ws + WS_POS))[nrow * 8 + F.lane]; wv = ((const float*)(p.ws + WS_WTS))[nrow * 8 + F.lane]; } }
        float ss = 0.f;
        FinBuf BB[2];
#pragma unroll
        for (int j = 0; j < 2; ++j) { const int q16 = F.lane + 64 * j, f0 = 256 * (q16 >> 4) + 32 * ((q16 >> 2) & 3) + 8 * (q16 & 3), f1 = f0 + 128; FinBuf& B = BB[j];
            B.y[0] = __builtin_nontemporal_load((const u32x4*)(YS + (size_t)row * D + q16 * 16));
#pragma unroll
            for (int r = 0; r < 8; ++r) B.y[1 + r] = __builtin_nontemporal_load((const u32x4*)(YS + (size_t)rows[r] * D + q16 * 16));
            B.xa = __builtin_nontemporal_load((const u32x4*)(xr + f0)); B.xb = __builtin_nontemporal_load((const u32x4*)(xr + f1));
            }
#pragma unroll
        for (int j = 0; j < 2; ++j) { const int q16 = F.lane + 64 * j, f0 = 256 * (q16 >> 4) + 32 * ((q16 >> 2) & 3) + 8 * (q16 & 3), f1 = f0 + 128; const FinBuf& B = BB[j];
            const f32x4 ga0 = *(const LAS f32x4*)(g2 + f0), ga1 = *(const LAS f32x4*)(g2 + f0 + 4), gb0 = *(const LAS f32x4*)(g2 + f1), gb1 = *(const LAS f32x4*)(g2 + f1 + 4);
            float a[16];
#pragma unroll
            for (int e = 0; e < 16; ++e) a[e] = 0.f;
            fin_acc(a, B.y[0], 0.0625f);
#pragma unroll
            for (int r = 0; r < 8; ++r) fin_acc(a, B.y[1 + r], w[r]);
            f32x4 v0, v1, v2, v3;
#pragma unroll
            for (int e = 0; e < 4; ++e) { const float xa0e = (e & 1) ? bfhi(B.xa[e >> 1]) : bflo(B.xa[e >> 1]), xa1e = (e & 1) ? bfhi(B.xa[2 + (e >> 1)]) : bflo(B.xa[2 + (e >> 1)]), xb0e = (e & 1) ? bfhi(B.xb[e >> 1]) : bflo(B.xb[e >> 1]), xb1e = (e & 1) ? bfhi(B.xb[2 + (e >> 1)]) : bflo(B.xb[2 + (e >> 1)]);
                v0[e] = xa0e + ga0[e] * a[e]; v1[e] = xa1e + ga1[e] * a[4 + e]; v2[e] = xb0e + gb0[e] * a[8 + e]; v3[e] = xb1e + gb1[e] * a[12 + e];
                ss += (v0[e] * v0[e] + v1[e] * v1[e]) + (v2[e] * v2[e] + v3[e] * v3[e]); }
            *(LAS f32x4*)(xs + f0) = v0; *(LAS f32x4*)(xs + f0 + 4) = v1; *(LAS f32x4*)(xs + f1) = v2; *(LAS f32x4*)(xs + f1 + 4) = v3; }
        const float rs = rsqrtf(wave_sum_dpp(ss) * (1.f / D) + EPS);
        float* orow = dst + (size_t)row * D;
#pragma unroll 1
        for (int j = 0; j < 4; ++j) { const int k = 8 * F.lane + 512 * j; const f32x4 f0 = *(const LAS f32x4*)(G2T + 4 * 2048 + k), f1 = *(const LAS f32x4*)(G2T + 4 * 2048 + k + 4);
            const f32x4 v0 = *(const LAS f32x4*)(xs + k), v1 = *(const LAS f32x4*)(xs + k + 4);
            __builtin_nontemporal_store(v0 * rs * f0, (f32x4*)(orow + k)); __builtin_nontemporal_store(v1 * rs * f1, (f32x4*)(orow + k + 4)); }
    }
}

__device__ __forceinline__ void ctx_piece(const P& p, const Fr& F, int piece) {
    const int mi = piece >> 4, ni = piece & 15, fr = F.lane & 15, q = F.lane >> 4, w = F.wave;
    const bf16* A = (const bf16*)(p.ws + WS_XN) + (size_t)(T + 64 * mi + fr) * D + w * 256 + 8 * q;
    const bf16* B = (const bf16*)(p.ws + WS_WIN_T) + (size_t)(64 * ni + fr) * D + w * 256 + 8 * q;
    f32x4 acc[4][4];
#pragma unroll
    for (int a = 0; a < 4; ++a)
#pragma unroll
        for (int b = 0; b < 4; ++b) acc[a][b] = (f32x4){0.f, 0.f, 0.f, 0.f};
#pragma unroll 1
    for (int s0 = 0; s0 < 8; s0 += 4) { bf16x8v af[4][4], bfr[4][4];
#pragma unroll
        for (int s = 0; s < 4; ++s)
#pragma unroll
            for (int t = 0; t < 4; ++t) { af[s][t] = *(const bf16x8v*)(A + (size_t)(16 * t) * D + (s0 + s) * 32); bfr[s][t] = *(const bf16x8v*)(B + (size_t)(16 * t) * D + (s0 + s) * 32); }
#pragma unroll
        for (int s = 0; s < 4; ++s)
#pragma unroll
            for (int a = 0; a < 4; ++a)
#pragma unroll
                for (int b = 0; b < 4; ++b) acc[a][b] = __builtin_amdgcn_mfma_f32_16x16x32_bf16(af[s][a], bfr[s][b], acc[a][b], 0, 0, 0); }
    LAS f32x4* part = (LAS f32x4*)F.lds;
#pragma unroll
    for (int a = 0; a < 4; ++a)
#pragma unroll
        for (int b = 0; b < 4; ++b) part[(w * 16 + a * 4 + b) * 64 + F.lane] = acc[a][b];
    __syncthreads();
    for (int o = F.tid; o < 1024; o += 512) { const int tile = o >> 6, ln = o & 63; f32x4 s = part[tile * 64 + ln];
#pragma unroll
        for (int ww = 1; ww < 8; ++ww) s += part[(ww * 16 + tile) * 64 + ln];
        const int a = tile >> 2, b = tile & 3, c = ln & 15, qq = ln >> 4; bf16* U = (bf16*)(p.ws + WS_U) + (size_t)(T + 64 * mi + 16 * a + 4 * qq) * DS + 64 * ni + 16 * b + c;
#pragma unroll
        for (int r = 0; r < 4; ++r) U[(size_t)r * DS] = (bf16)f2bf(s[r]); }
    __syncthreads();
}
__device__ __forceinline__ void moe1_conv_share(const Fr& F, int& first, int& count) {
    constexpr int U_ITEMS = 44;
    LAS int* NU = (LAS int*)F.lds;
    const int ntot = (int)F.misc[MW_UPRE + 65] * 4, chunk = (ntot + 7) >> 3;
    { const int base = CVS_DOWN / F.G, rem = CVS_DOWN % F.G; first = F.bid * base + (F.bid < rem ? F.bid : rem); count = base + (F.bid < rem ? 1 : 0); }
    if (F.G != 256) return;
    if (F.tid < 256) { const int x = F.tid & 7, j = F.tid >> 3; int len = ntot - x * chunk; len = len < chunk ? len : chunk; NU[F.tid] = j < len ? (len - 1 - j) / 32 + 1 : 0; }
    __syncthreads();
    int mx = 0;
    for (int b = 0; b < 256; b += 4) { const pg8::v4i_t v = *(const LAS pg8::v4i_t*)(NU + b); mx = max(max(mx, v[0]), max(max(v[1], v[2]), v[3])); }
    int below = 0, tot = 0;
    for (int b = 0; b < 256; b += 4) { const pg8::v4i_t v = *(const LAS pg8::v4i_t*)(NU + b);
#pragma unroll
        for (int i = 0; i < 4; ++i) { const int d = (mx - v[i]) * U_ITEMS; tot += d; below += (b + i < F.bid) ? d : 0; } }
    const int mine = (mx - NU[F.bid]) * U_ITEMS;
    __syncthreads();
    if (tot <= CVS_DOWN) { const int base = (CVS_DOWN - tot) / 256, rem = (CVS_DOWN - tot) % 256; first = F.bid * base + (F.bid < rem ? F.bid : rem) + below; count = base + (F.bid < rem ? 1 : 0) + mine; }
    first = __builtin_amdgcn_readfirstlane(first); count = __builtin_amdgcn_readfirstlane(count);
}
enum { PH_MOD = 0, PH_PRE, PH_INPROJ, PH_SSM, PH_GLU, PH_OUT, PH_ROUTE, PH_MOE1, PH_MOE2, PH_FINAL, PH_N };
struct Args { P p; int lo, hi, pad0, pad1; };
__global__ void __launch_bounds__(NWAVES * 64, 2) mk_fast(Args a) {
    extern __shared__ __attribute__((aligned(16))) unsigned char lds_raw[];
    const P& p = a.p;
    Fr F; F.lds = (LAS unsigned char*)lds_raw; F.misc = (volatile LAS unsigned*)(F.lds + MISC_OFF);
    F.tid = threadIdx.x; F.lane = F.tid & 63; F.wave = __builtin_amdgcn_readfirstlane(F.tid >> 6); F.G = gridDim.x; F.bid = blockIdx.x;
    if (F.tid < 16) F.misc[F.tid] = 0u;
    __syncthreads();
    XcdBarrier bar = xcd_barrier_post((unsigned*)p.ws + CW_BAR, F.misc + MW_BAR);
    unsigned char* ws = p.ws;
    const bool cv_early = (F.bid >> 3) < (F.G >> 4);
#define CVSL(set, a, b) conv_slice(p, F, set, (int)((long long)(set == 0 ? CVS_UP : CVS_DOWN) * (a) / 100) + F.bid * NWAVES, (int)((long long)(set == 0 ? CVS_UP : CVS_DOWN) * (b) / 100), F.G * NWAVES)
    const int lo = a.lo, hi = a.hi;
#define IN(k) (lo <= (k) && (k) < hi)
#define SEAM(k) do { if (IN(k) && IN((k) + 1)) xcd_barrier(bar); } while (0)
    if (IN(PH_MOD)) { ph_mod(p, F); } SEAM(PH_MOD);
    if (IN(PH_PRE)) { ph_pre(p, F); } SEAM(PH_PRE);
    const bool ctx_units = (F.G == 256), ctx_wg = ctx_units && F.bid < 16;
    const int cv_in_hi = (int)((long long)CVS_UP * 45 / 100);
#define CVSL_IN() do { if (!ctx_units) conv_slice(p, F, 0, F.bid * NWAVES, cv_in_hi, F.G * NWAVES); else if (!ctx_wg) conv_slice(p, F, 0, (F.bid - 16) * NWAVES, cv_in_hi, (F.G - 16) * NWAVES); } while (0)
    if (IN(PH_INPROJ)) { if (cv_early) CVSL_IN(); }
    if (IN(PH_INPROJ)) {
        SDense S{(const char*)(ws + WS_XN), (const char*)(ws + WS_WIN_T), 32, 16, ctx_units ? 16 : 0, 4, 2048, F.G, F.bid};
        EpiInProj E{(bf16*)(ws + WS_U), (bf16*)(ws + WS_BG), (bf16*)(ws + WS_Z)};
        pg8::gemm_phase<EpiInProj, SDense, true, false>(F.lds, nullptr, 2048, S, E);
        if (!ctx_units) for (int piece = F.bid; piece < 256; piece += F.G) ctx_piece(p, F, piece);
    }
    if (IN(PH_INPROJ)) { if (!cv_early) CVSL_IN(); } SEAM(PH_INPROJ);
    if (IN(PH_SSM)) { if (cv_early) CVSL(0, 45, 70); }
    if (IN(PH_SSM)) { ph_ssm(p, F); }
    if (IN(PH_SSM)) { if (!cv_early) CVSL(0, 45, 70); } SEAM(PH_SSM);
    if (IN(PH_GLU)) {
        SDense S{(const char*)(ws + WS_GY), (const char*)(ws + WS_WGLU_T), 32, 8, 0, 1, 1024, F.G, F.bid};
        EpiGlu E{(bf16*)(ws + WS_HEADS), p.mix_g, (float*)(ws + WS_RSP_SSM)};
        pg8::gemm_phase<EpiGlu, SDense, true, false>(F.lds, nullptr, 1024, S, E);
    } SEAM(PH_GLU);
    if (IN(PH_OUT)) { if (cv_early) CVSL(0, 70, 100); }
    if (IN(PH_OUT)) {
        SDense S{(const char*)(ws + WS_HEADS), (const char*)(ws + WS_WOUT_T), 32, 8, 0, 1, 2048, F.G, F.bid};
        EpiOut E{p.x, (bf16*)(ws + WS_X1B), (const float*)(ws + WS_MOD), (const float*)(ws + WS_RSP_SSM), (float*)(ws + WS_RSP_X1)};
        pg8::gemm_phase<EpiOut, SDense, true, false>(F.lds, nullptr, 2048, S, E);
    }
    if (IN(PH_OUT)) { if (!cv_early) CVSL(0, 70, 100); } SEAM(PH_OUT);
    if (IN(PH_ROUTE)) { ph_route(p, F); } SEAM(PH_ROUTE);
    int cfirst = 0, ccount = 0;
    if (IN(PH_MOE1)) { moe_tables(p, F); moe1_conv_share(F, cfirst, ccount); if (cv_early) conv_slice(p, F, 1, cfirst, cfirst + ccount, NWAVES); }
    if (IN(PH_MOE1)) {
        SMoe<4, true> S{F.misc, ws, 2048, F.G, F.bid}; S.build_list();
        EpiAct E{ws + WS_ACT};
        pg8::gemm_phase<EpiAct, SMoe<4, true>, true, true, true>(F.lds, (LAS unsigned*)(F.lds + MISC_OFF) + MW_TAB, 2048, S, E);
    }
    if (IN(PH_MOE1)) { if (!cv_early) conv_slice(p, F, 1, cfirst, cfirst + ccount, NWAVES); } SEAM(PH_MOE1);
    if (IN(PH_MOE2)) {
        if (!IN(PH_MOE1)) moe_tables(p, F);
        SMoe<8, false> S{F.misc, ws, 512, F.G, F.bid}; S.build_list();
        EpiY E{ws + WS_YS};
        pg8::gemm_phase<EpiY, SMoe<8, false>, true, false, true>(F.lds, nullptr, 512, S, E);
    } SEAM(PH_MOE2);
    if (IN(PH_FINAL)) { if (!IN(PH_MOE1)) moe_tables(p, F); ph_final(p, F); }
#undef IN
#undef SEAM
#undef CVSL
#undef CVSL_IN
}

extern "C" void kernel_launch(void* const* d_in, const int* in_sizes, int n_in, void* d_out, int out_size, void* d_ws, size_t ws_size, hipStream_t stream) {
    if (n_in != 31 || out_size != T * D || ws_size < WS_END) { fprintf(stderr, "kernel_launch: unexpected sizes n_in %d out %d ws %zu (need %zu)\n", n_in, out_size, ws_size, (size_t)WS_END); return; }
    static int grid = 0;
    if (grid == 0) {
        int dev = 0, cus = 0, per_cu = 0;
        if (hipGetDevice(&dev) != hipSuccess || hipDeviceGetAttribute(&cus, hipDeviceAttributeMultiprocessorCount, dev) != hipSuccess) { fprintf(stderr, "kernel_launch: device query failed\n"); grid = -1; return; }
        if (hipFuncSetAttribute((const void*)mk_fast, hipFuncAttributeMaxDynamicSharedMemorySize, LDS_BYTES) != hipSuccess) { fprintf(stderr, "kernel_launch: hipFuncSetAttribute failed\n"); grid = -1; return; }
        if (hipOccupancyMaxActiveBlocksPerMultiprocessor(&per_cu, (const void*)mk_fast, NWAVES * 64, LDS_BYTES) != hipSuccess || per_cu < 1) { fprintf(stderr, "kernel_launch: occupancy query says %d blocks/CU\n", per_cu); grid = -1; return; }
        grid = cus;
        fprintf(stderr, "kernel_launch: grid %d (occupancy query %d/CU)\n", grid, per_cu);
    }
    if (grid < 0) return;
    Args a{}; a.lo = 0; a.hi = PH_N;
    const float** f = (const float**)&a.p;
    for (int i = 0; i < 31; ++i) f[i] = (const float*)d_in[i];
    a.p.out = (float*)d_out; a.p.ws = (unsigned char*)d_ws;
    (void)hipMemsetAsync((char*)d_ws + CW_BAR * 4, 0, XCD_BAR_WORDS * 4, stream);
    hipLaunchKernelGGL(mk_fast, dim3(grid), dim3(NWAVES * 64), LDS_BYTES, stream, a);
}
```
